# Optimizing an MI355X kernel written in HIP

```python
import jax, jax.numpy as jnp
from jax import lax
import numpy as np

D_MODEL = 1024
BATCH = 4
SEQ = 8192
DEPTH = 2

MIX_WIDTH = D_MODEL
POOL_WINDOWS = (2, 4, 8, 16)
POOL_GROUPS = len(POOL_WINDOWS)
POOL_WIDTH = D_MODEL // 4
POOL_GROUP_DIM = POOL_WIDTH // POOL_GROUPS
SGU_CHUNK = 128
SGU_HEADS = 4
SGU_WIDTH = D_MODEL // 2
SGU_HEAD_DIM = SGU_WIDTH // SGU_HEADS
FNET_HEADS = 4
FNET_WIDTH = D_MODEL // 4
FNET_HEAD_DIM = FNET_WIDTH // FNET_HEADS
IN_PROJ_WIDTH = POOL_WIDTH + 2 * SGU_WIDTH + FNET_WIDTH
MEM_LEN = 256
XA_HEADS = 4
XA_HEAD_DIM = D_MODEL // XA_HEADS
FFN_HIDDEN = -(-8 * D_MODEL // (3 * 256)) * 256
RMS_EPS = 1e-6
LN_EPS = 1e-5

kernel_name = "hybrid_pool_sgu_fourier_encoder"


def _rmsnorm(x, g):
    xf = x.astype(jnp.float32)
    y = xf * lax.rsqrt(jnp.mean(xf * xf, axis=-1, keepdims=True) + RMS_EPS)
    return (y * g.astype(jnp.float32)).astype(x.dtype)


def _layernorm(x, g):
    xf = x.astype(jnp.float32)
    mu = jnp.mean(xf, axis=-1, keepdims=True)
    xc = xf - mu
    y = xc * lax.rsqrt(jnp.mean(xc * xc, axis=-1, keepdims=True) + LN_EPS)
    return (y * g.astype(jnp.float32)).astype(x.dtype)


def _pool_mixer(xa, w, scale):
    b, s, _ = xa.shape
    xf = xa.astype(jnp.float32)
    csum = jnp.concatenate(
        [jnp.zeros((b, 1, POOL_WIDTH), jnp.float32), lax.cumsum(xf, axis=1)], axis=1)
    t = jnp.arange(s)
    pooled = []
    for g, win in enumerate(POOL_WINDOWS):
        left = win // 2
        right = win - 1 - left
        lo = jnp.clip(t - left, 0, s - 1)
        hi = jnp.clip(t + right, 0, s - 1)
        cg = csum[..., g * POOL_GROUP_DIM:(g + 1) * POOL_GROUP_DIM]
        window_sum = jnp.take(cg, hi + 1, axis=1) - jnp.take(cg, lo, axis=1)
        count = (hi - lo + 1).astype(jnp.float32)[None, :, None]
        pooled.append(window_sum / count)
    pooled = jnp.stack(pooled, axis=2)
    diff = (pooled - xf.reshape(b, s, POOL_GROUPS, POOL_GROUP_DIM)).astype(xa.dtype)
    y = jnp.einsum('bsgc,gcd->bsgd', diff, w).reshape(b, s, POOL_WIDTH)
    return y * scale


def _spatial_gating(u, v, v_gain, w_s, b_s):
    b, s, _ = u.shape
    v = _layernorm(v, v_gain)
    vc = v.reshape(b, s // SGU_CHUNK, SGU_CHUNK, SGU_HEADS, SGU_HEAD_DIM)
    mixed = jnp.einsum('hpq,bnqhc->bnphc', w_s, vc) + jnp.transpose(b_s)[None, None, :, :, None]
    return u * mixed.reshape(b, s, SGU_WIDTH)


def _fourier_mixer(xc, w):
    b, s, _ = xc.shape
    xh = xc.astype(jnp.float32).reshape(b, s, FNET_HEADS, FNET_HEAD_DIM)
    f = jnp.fft.fftn(xh, axes=(1, 3), norm='ortho').real.astype(xc.dtype)
    return jnp.einsum('bshc,hcd->bshd', f, w).reshape(b, s, FNET_WIDTH)


def _memory_attention(h, m, wq, wk, wv, wo):
    b, s, _ = h.shape
    q = (h @ wq).reshape(b, s, XA_HEADS, XA_HEAD_DIM)
    k = (m @ wk).reshape(b, MEM_LEN, XA_HEADS, XA_HEAD_DIM)
    v = (m @ wv).reshape(b, MEM_LEN, XA_HEADS, XA_HEAD_DIM)
    scores = jnp.einsum('bshd,bmhd->bhsm', q, k).astype(jnp.float32) * (XA_HEAD_DIM ** -0.5)
    p = jax.nn.softmax(scores, axis=-1).astype(h.dtype)
    o = jnp.einsum('bhsm,bmhd->bshd', p, v).reshape(b, s, D_MODEL)
    return o @ wo


def _swiglu(h, wg, wu, wd):
    return (jax.nn.silu(h @ wg) * (h @ wu)) @ wd


def setup_inputs(seed: int = 0) -> dict:
    key = jax.random.key(seed)
    ks = jax.random.split(key, 32)
    L, D = DEPTH, D_MODEL

    def nrm(k, shape, fan_in):
        return jax.random.normal(k, shape, jnp.float32) * (fan_in ** -0.5)

    def gain(k, shape):
        return 1.0 + 0.05 * jax.random.normal(k, shape, jnp.float32)

    return {
        "x": jax.random.normal(ks[0], (BATCH, SEQ, D), jnp.float32),
        "mem": jax.random.normal(ks[1], (BATCH, MEM_LEN, D), jnp.float32),
        "ln_mix_pre": gain(ks[2], (L, D)),
        "w_in": nrm(ks[3], (L, D, IN_PROJ_WIDTH), D),
        "pool_w": nrm(ks[4], (L, POOL_GROUPS, POOL_GROUP_DIM, POOL_GROUP_DIM), POOL_GROUP_DIM),
        "pool_scale": gain(ks[5], (L, POOL_WIDTH)),
        "sgu_norm": gain(ks[6], (L, SGU_WIDTH)),
        "sgu_w": nrm(ks[7], (L, SGU_HEADS, SGU_CHUNK, SGU_CHUNK), SGU_CHUNK),
        "sgu_b": gain(ks[8], (L, SGU_HEADS, SGU_CHUNK)),
        "fnet_w": nrm(ks[9], (L, FNET_HEADS, FNET_HEAD_DIM, FNET_HEAD_DIM), FNET_HEAD_DIM),
        "w_out": nrm(ks[10], (L, MIX_WIDTH, D), MIX_WIDTH),
        "ln_mix_post": gain(ks[11], (L, D)),
        "ln_xa_pre": gain(ks[12], (L, D)),
        "ln_mem": gain(ks[13], (L, D)),
        "xa_wq": nrm(ks[14], (L, D, D), D),
        "xa_wk": nrm(ks[15], (L, D, D), D),
        "xa_wv": nrm(ks[16], (L, D, D), D),
        "xa_wo": nrm(ks[17], (L, D, D), D),
        "ln_xa_post": gain(ks[18], (L, D)),
        "ln_ffn_pre": gain(ks[19], (L, D)),
        "ffn_wg": nrm(ks[20], (L, D, FFN_HIDDEN), D),
        "ffn_wu": nrm(ks[21], (L, D, FFN_HIDDEN), D),
        "ffn_wd": nrm(ks[22], (L, FFN_HIDDEN, D), FFN_HIDDEN),
        "ln_ffn_post": gain(ks[23], (L, D)),
    }


def reference(x, mem, ln_mix_pre, w_in, pool_w, pool_scale, sgu_norm, sgu_w, sgu_b,
              fnet_w, w_out, ln_mix_post, ln_xa_pre, ln_mem, xa_wq, xa_wk, xa_wv,
              xa_wo, ln_xa_post, ln_ffn_pre, ffn_wg, ffn_wu, ffn_wd, ln_ffn_post):
    s_a = POOL_WIDTH
    s_u = s_a + SGU_WIDTH
    s_v = s_u + SGU_WIDTH
    for l in range(DEPTH):
        h = _rmsnorm(x, ln_mix_pre[l])
        z = h @ w_in[l]
        za = z[..., :s_a]
        zu = z[..., s_a:s_u]
        zv = z[..., s_u:s_v]
        zc = z[..., s_v:]
        ya = _pool_mixer(za, pool_w[l], pool_scale[l])
        yb = _spatial_gating(zu, zv, sgu_norm[l], sgu_w[l], sgu_b[l])
        yc = _fourier_mixer(zc, fnet_w[l])
        y = jnp.concatenate([ya, yb, yc], axis=-1) @ w_out[l]
        x = x + _rmsnorm(y, ln_mix_post[l])
        m = _rmsnorm(mem, ln_mem[l])
        h = _rmsnorm(x, ln_xa_pre[l])
        y = _memory_attention(h, m, xa_wq[l], xa_wk[l], xa_wv[l], xa_wo[l])
        x = x + _rmsnorm(y, ln_xa_post[l])
        h = _rmsnorm(x, ln_ffn_pre[l])
        y = _swiglu(h, ffn_wg[l], ffn_wu[l], ffn_wd[l])
        x = x + _rmsnorm(y, ln_ffn_post[l])
    return x
```

```cpp
#include <hip/hip_runtime.h>
#include <hip/hip_cooperative_groups.h>
#include <cstdio>
#include <cstdint>
namespace cg = cooperative_groups;

#ifndef MK_PER_PHASE
#define MK_PER_PHASE 0
#endif

#ifndef DBG_MASK
#define DBG_MASK 0xFFFFFFFFu
#endif
#define DBG(b) ((DBG_MASK >> (b)) & 1u)
#define LAS __attribute__((address_space(3)))
typedef unsigned short bf16_t;
typedef short bf16x8 __attribute__((ext_vector_type(8)));
typedef float f32x4 __attribute__((ext_vector_type(4)));
typedef float f32x2 __attribute__((ext_vector_type(2)));
typedef unsigned u32x4 __attribute__((ext_vector_type(4)));
typedef unsigned u32x2 __attribute__((ext_vector_type(2)));

constexpr int NB = 4, SEQ = 8192, DM = 1024, MT = NB * SEQ, NL = 2;
constexpr int NZ = 1792;
constexpr int FF = 2816, FF2 = 5632;
constexpr int MROWS = 1024;
constexpr float RMS_EPS = 1e-6f, LN_EPS = 1e-5f;

constexpr size_t MiB = 1u << 20;
constexpr size_t WS_F1 = 0, WS_F2 = 64 * 1024, WS_TWC = 192 * 1024, WS_TWS = 224 * 1024, WS_RSMEM = 256 * 1024;
constexpr size_t WS_RS = 1 * MiB, WS_MEMB = 2 * MiB, WS_KB = 4 * MiB, WS_VT = 8 * MiB;
constexpr size_t WS_W = 16 * MiB, W_LAYER = 32 * MiB;
constexpr size_t W_IN = 0, W_OUT = 4 * MiB, W_Q = 6 * MiB, W_K = 8 * MiB, W_V = 10 * MiB, W_O = 12 * MiB, W_GU = 14 * MiB, W_D = 25 * MiB, W_SGU = 31 * MiB;
constexpr size_t WS_XB = 80 * MiB, WS_Y = 144 * MiB, WS_R = 208 * MiB;
constexpr size_t R_Z = 0, R_CAT = 112 * MiB, R_A1 = 176 * MiB, R_A2 = 208 * MiB;
constexpr size_t R_Q = 0, R_P = 64 * MiB;
constexpr size_t R_ACT = 0;
constexpr size_t WS_END = 448 * MiB;

constexpr int LDS_BYTES = 147456;
constexpr int XCH_OFF = 131072;

__device__ __forceinline__ unsigned f2bf(float f) { unsigned u = __builtin_bit_cast(unsigned, f); return (u + 0x7fffu + ((u >> 16) & 1u)) >> 16; }
__device__ __forceinline__ unsigned pk2(float lo, float hi) { return f2bf(lo) | (f2bf(hi) << 16); }
__device__ __forceinline__ float bflo(unsigned w) { return __builtin_bit_cast(float, w << 16); }
__device__ __forceinline__ float bfhi(unsigned w) { return __builtin_bit_cast(float, w & 0xffff0000u); }
__device__ __forceinline__ unsigned cvt_pk_bf16(float lo, float hi) { unsigned r; asm volatile("v_cvt_pk_bf16_f32 %0, %1, %2" : "=v"(r) : "v"(lo), "v"(hi)); return r; }
__device__ __forceinline__ float wave_sum(float v) {
#pragma unroll
    for (int o = 1; o < 64; o <<= 1) v += __shfl_xor(v, o);
    return v;
}
#define LDS_WAIT() asm volatile("s_waitcnt lgkmcnt(0)" ::: "memory")

namespace pg8 {
#define PG8_LAS __attribute__((address_space(3)))
constexpr int BM = 256, BK = 64, HALF = 128, HTB = HALF * BK * 2  , STAGE_BYTES = 8 * HTB, NXCD = 8, WGM = 8;

__host__ __device__ __forceinline__ int lds_byte(int r, int c) { const int st = (r >> 4) * 2 + (c >> 5), rr = r & 15, cc = c & 31, ob = rr * 64 + cc * 2; return st * 1024 + (ob ^ (((ob >> 9) & 1) << 5)); }
__host__ __device__ __forceinline__ void stage_rc(int b, int& R, int& C) { const int st = b / 1024, sb = b % 1024, swz = sb ^ (((sb >> 9) & 1) << 5); R = (st >> 1) * 16 + swz / 64; C = (st & 1) * 32 + (swz % 64) / 2; }
__host__ __device__ __forceinline__ int perm32(int rho) { const int n = rho >> 4, i = rho & 15; return 8 * (i >> 2) + 4 * n + (i & 3); }

struct Unit { int pm, pn; };
struct Gemm { const bf16_t* A; const bf16_t* Bt; int lda, ldb, K, nM, nN, b_div; long a_pm, a_pn, b_pn, b_pq; };
__device__ __forceinline__ Gemm mk_gemm(const bf16_t* A, int lda, const bf16_t* Bt, int ldb, int K, int nM, int nN) {
    Gemm g; g.A = A; g.Bt = Bt; g.lda = lda; g.ldb = ldb; g.K = K; g.nM = nM; g.nN = nN; g.b_div = 1;
    g.a_pm = 512L * lda; g.a_pn = 0; g.b_pn = 512L * ldb; g.b_pq = 0; return g;
}

struct StaticOrder {
    int nM, nN, nwg, G, c;
    __host__ __device__ void init(int nM_, int nN_, int G_, int c_) { nM = nM_; nN = nN_; nwg = nM * nN; G = G_; c = c_; }
    __host__ __device__ bool next(int i, Unit& u) const {
        const long L = (long)i * G + c; if (L >= nwg) return false;
        int wgid = (int)L; { const int q = nwg / NXCD, r = nwg % NXCD, xcd = wgid % NXCD, off = wgid / NXCD; wgid = (xcd < r ? xcd * (q + 1) : r * (q + 1) + (xcd - r) * q) + off; }
        const int nig = WGM * nN, gid = wgid / nig, fm = gid * WGM, gsz = (nM - fm) < WGM ? (nM - fm) : WGM;
        u.pm = fm + ((wgid % nig) % gsz); u.pn = (wgid % nig) / gsz; return true;
    }
};

typedef f32x4 Acc[2][2][4][2];

__device__ __forceinline__ u32x4 pack8(f32x4 v0, f32x4 v1) { u32x4 w; w.x = cvt_pk_bf16(v0[0], v0[1]); w.y = cvt_pk_bf16(v0[2], v0[3]); w.z = cvt_pk_bf16(v1[0], v1[1]); w.w = cvt_pk_bf16(v1[2], v1[3]); return w; }

struct EpiRow {
    static constexpr bool PERM = true;
    bf16_t* O; int ldc; const float* rs;
    __device__ __forceinline__ void operator()(Acc& acc, const Unit& u, int wr, int wc, int fr, int fq, int ui) const {
        asm volatile("" : "+v"(fr), "+v"(fq));
        const int row0 = u.pm * BM + wr * 64 + fr, col0 = u.pn * BM + wc * 32 + 8 * fq;
#pragma unroll
        for (int ai = 0; ai < 2; ++ai)
#pragma unroll
            for (int m = 0; m < 4; ++m) { const int row = row0 + ai * HALF + m * 16; const float s = rs ? rs[row] : 1.f; bf16_t* rowp = O + (size_t)row * ldc + col0;
#pragma unroll
                for (int bj = 0; bj < 2; ++bj) *(u32x4*)(rowp + bj * HALF) = pack8(acc[ai][bj][m][0] * s, acc[ai][bj][m][1] * s); }
    }
};
struct EpiCol {
    static constexpr bool PERM = true;
    bf16_t* O; int ldc; const float* cs;
    __device__ __forceinline__ void operator()(Acc& acc, const Unit& u, int wr, int wc, int fr, int fq, int ui) const {
        asm volatile("" : "+v"(fr), "+v"(fq));
        const int row0 = u.pm * BM + wr * 64 + fr, col0 = u.pn * BM + wc * 32 + 8 * fq;
        f32x4 sv[2][2];
#pragma unroll
        for (int bj = 0; bj < 2; ++bj)
#pragma unroll
            for (int n = 0; n < 2; ++n) sv[bj][n] = *(const f32x4*)(cs + col0 + bj * HALF + 4 * n);
#pragma unroll
        for (int ai = 0; ai < 2; ++ai)
#pragma unroll
            for (int m = 0; m < 4; ++m) { const int row = row0 + ai * HALF + m * 16; bf16_t* rowp = O + (size_t)row * ldc + col0;
#pragma unroll
                for (int bj = 0; bj < 2; ++bj) *(u32x4*)(rowp + bj * HALF) = pack8(acc[ai][bj][m][0] * sv[bj][0], acc[ai][bj][m][1] * sv[bj][1]); }
    }
};
struct EpiSwiGLU {
    static constexpr bool PERM = true;
    bf16_t* O; int ldc; const float* rs;
    __device__ __forceinline__ void operator()(Acc& acc, const Unit& u, int wr, int wc, int fr, int fq, int ui) const {
        asm volatile("" : "+v"(fr), "+v"(fq));
        const int row0 = u.pm * BM + wr * 64 + fr, col0 = u.pn * HALF + wc * 32 + 8 * fq;
#pragma unroll
        for (int ai = 0; ai < 2; ++ai)
#pragma unroll
            for (int m = 0; m < 4; ++m) { const int row = row0 + ai * HALF + m * 16; const float s = rs[row];
                f32x4 o[2];
#pragma unroll
                for (int n = 0; n < 2; ++n) { const f32x4 g = acc[ai][0][m][n] * s, up = acc[ai][1][m][n] * s;
#pragma unroll
                    for (int i = 0; i < 4; ++i) o[n][i] = g[i] * __builtin_amdgcn_rcpf(1.f + __expf(-g[i])) * up[i]; }
                *(u32x4*)(O + (size_t)row * ldc + col0) = pack8(o[0], o[1]); }
    }
};
struct EpiSoftmax {
    static constexpr bool PERM = true;
    bf16_t* P; int ldc; PG8_LAS unsigned char* xl;
    __device__ __forceinline__ void operator()(Acc& acc, const Unit& u, int wr, int wc, int fr, int fq, int ui) const {
        asm volatile("" : "+v"(fr), "+v"(fq));
        PG8_LAS f32x2* X = (PG8_LAS f32x2*)(xl + (ui & 1) * 8192);
        float lm[2][4];
#pragma unroll
        for (int ai = 0; ai < 2; ++ai)
#pragma unroll
            for (int m = 0; m < 4; ++m) {
                float mx = -3.0e38f;
#pragma unroll
                for (int bj = 0; bj < 2; ++bj)
#pragma unroll
                    for (int n = 0; n < 2; ++n) { const f32x4 v = acc[ai][bj][m][n]; mx = fmaxf(mx, fmaxf(fmaxf(v[0], v[1]), fmaxf(v[2], v[3]))); }
                mx = fmaxf(mx, __shfl_xor(mx, 16)); mx = fmaxf(mx, __shfl_xor(mx, 32));
                float s = 0.f;
#pragma unroll
                for (int bj = 0; bj < 2; ++bj)
#pragma unroll
                    for (int n = 0; n < 2; ++n) { f32x4 v = acc[ai][bj][m][n];
#pragma unroll
                        for (int i = 0; i < 4; ++i) { v[i] = __expf(v[i] - mx); s += v[i]; }
                        acc[ai][bj][m][n] = v; }
                s += __shfl_xor(s, 16); s += __shfl_xor(s, 32);
                if (fq == 0) X[(ai * HALF + wr * 64 + m * 16 + fr) * 4 + wc] = (f32x2){mx, s};
                lm[ai][m] = mx;
            }
        asm volatile("s_waitcnt lgkmcnt(0)" ::: "memory"); __builtin_amdgcn_s_barrier(); asm volatile("" ::: "memory");
#pragma unroll
        for (int ai = 0; ai < 2; ++ai)
#pragma unroll
            for (int m = 0; m < 4; ++m) { const int r = ai * HALF + wr * 64 + m * 16 + fr;
                const f32x2 e0 = X[r * 4 + 0], e1 = X[r * 4 + 1], e2 = X[r * 4 + 2], e3 = X[r * 4 + 3];
                const float gm = fmaxf(fmaxf(e0.x, e1.x), fmaxf(e2.x, e3.x));
                const float tot = e0.y * __expf(e0.x - gm) + e1.y * __expf(e1.x - gm) + e2.y * __expf(e2.x - gm) + e3.y * __expf(e3.x - gm);
                const float f = __expf(lm[ai][m] - gm) / tot;
                bf16_t* rowp = P + (size_t)(u.pm * BM + r) * ldc + u.pn * BM + wc * 32 + 8 * fq;
#pragma unroll
                for (int bj = 0; bj < 2; ++bj) *(u32x4*)(rowp + bj * HALF) = pack8(acc[ai][bj][m][0] * f, acc[ai][bj][m][1] * f); }
    }
};
struct EpiFFT1 {
    static constexpr bool PERM = true;
    bf16_t* A2; const float* twc_; const float* tws_;
    __device__ __forceinline__ void operator()(Acc& acc, const Unit& u, int wr, int wc, int fr, int fq, int ui) const {
        asm volatile("" : "+v"(fr), "+v"(fq));
        if (wr != 0) return;
        const float* twc = twc_; const float* tws = tws_;
        asm volatile("" : "+s"(twc), "+s"(tws));
        const int s20 = wc * 32 + 8 * fq;
#pragma unroll
        for (int m = 0; m < 4; ++m) { const int k1 = 16 * m + fr;
#pragma unroll
            for (int n = 0; n < 2; ++n) { const f32x4 c4 = *(const f32x4*)(twc + k1 * 128 + s20 + 4 * n), s4 = *(const f32x4*)(tws + k1 * 128 + s20 + 4 * n);
#pragma unroll
                for (int bj = 0; bj < 2; ++bj) { const f32x4 tr = acc[0][bj][m][n], ti = acc[1][bj][m][n]; acc[0][bj][m][n] = tr * c4 + ti * s4; acc[1][bj][m][n] = ti * c4 - tr * s4; } }
#pragma unroll
            for (int bj = 0; bj < 2; ++bj) { const int bc = u.pn * 2 + bj, b = bc >> 8, c = bc & 255;
                bf16_t* dst = A2 + ((size_t)((b * 64 + k1) * 256 + c)) * 256 + s20;
                *(u32x4*)dst = pack8(acc[0][bj][m][0], acc[0][bj][m][1]);
                *(u32x4*)(dst + 128) = pack8(acc[1][bj][m][0], acc[1][bj][m][1]); } }
    }
};
struct EpiFFT2 {
    static constexpr bool PERM = true;
    bf16_t* cat;
    __device__ __forceinline__ void operator()(Acc& acc, const Unit& u, int wr, int wc, int fr, int fq, int ui) const {
        asm volatile("" : "+v"(fr), "+v"(fq));
        const int b = u.pn >> 6, k1 = u.pn & 63;
#pragma unroll
        for (int m = 0; m < 4; ++m) { const int k2 = 64 * wr + 16 * m + fr; const size_t token = (size_t)b * SEQ + k1 + 64 * k2;
            bf16_t* rowp = cat + token * DM + 768 + wc * 32 + 8 * fq;
#pragma unroll
            for (int bj = 0; bj < 2; ++bj) *(u32x4*)(rowp + bj * HALF) = pack8(acc[0][bj][m][0], acc[0][bj][m][1]); }
    }
};

template <class Epi>
__device__ __forceinline__ void gemm_phase(PG8_LAS unsigned char* lds, const Gemm g, const StaticOrder& S, const Epi& E) {
    int tid = threadIdx.x; asm volatile("" : "+v"(tid));
    const int wid = __builtin_amdgcn_readfirstlane(tid >> 6), lane = tid & 63, wr = wid >> 2, wc = wid & 3, fr = lane & 15, fq = lane >> 4;
    const int K = g.K, nt = K / BK;
    unsigned voffA[2], voffB[2];
#pragma unroll
    for (int i = 0; i < 2; ++i) { int R, C; stage_rc(tid * 16 + i * 8192, R, C); const int Rb = Epi::PERM ? ((R & ~31) + perm32(R & 31)) : R;
        voffA[i] = (unsigned)(R * g.lda + C) * 2u; voffB[i] = (unsigned)(Rb * g.ldb + C) * 2u; }
    const size_t kstep = (size_t)(BK * 2);
    const size_t hstepA = (size_t)HALF * g.lda * 2, hstepB = (size_t)HALF * g.ldb * 2;
    const unsigned ldsw = (unsigned)wid * 1024u;
    const int aoff = lds_byte(wr * 64 + fr, fq * 8), boff = lds_byte(wc * 32 + fr, fq * 8);
#define PG8_ABASE(u) ((const char*)g.A + (size_t)(u).pm * g.a_pm + (size_t)(u).pn * g.a_pn)
#define PG8_BBASE(u) ((const char*)g.Bt + (size_t)(u).pn * g.b_pn + (size_t)((u).pm / g.b_div) * g.b_pq)
#define PG8_SA(b, h) (((b) * 2 + (h)) * HTB)
#define PG8_SB(b, h) ((4 + (b) * 2 + (h)) * HTB)
#define PG8_STAGE(bufoff, gbase, voff) do { _Pragma("unroll") for (int _i = 0; _i < 2; ++_i) \
        __builtin_amdgcn_global_load_lds((const unsigned*)((const char*)(gbase) + (voff)[_i]), (PG8_LAS unsigned*)(lds + (bufoff) + ldsw + _i * 8192), 16, 0, 0); } while (0)
#define PG8_LDA(dst, b, h) do { _Pragma("unroll") for (int m = 0; m < 4; ++m) _Pragma("unroll") for (int k = 0; k < 2; ++k) dst[m][k] = *(const PG8_LAS bf16x8*)(lds + PG8_SA(b, h) + aoff + m * 2048 + k * 1024); } while (0)
#define PG8_LDB(dst, b, h) do { _Pragma("unroll") for (int n = 0; n < 2; ++n) _Pragma("unroll") for (int k = 0; k < 2; ++k) dst[n][k] = *(const PG8_LAS bf16x8*)(lds + PG8_SB(b, h) + boff + n * 2048 + k * 1024); } while (0)
#define PG8_MMA(ai, bj, At, Bt) do { __builtin_amdgcn_s_setprio(1); _Pragma("unroll") for (int m = 0; m < 4; ++m) _Pragma("unroll") for (int n = 0; n < 2; ++n) _Pragma("unroll") for (int k = 0; k < 2; ++k) \
        acc[ai][bj][m][n] = __builtin_amdgcn_mfma_f32_16x16x32_bf16(Bt[n][k], At[m][k], acc[ai][bj][m][n], 0, 0, 0); __builtin_amdgcn_s_setprio(0); } while (0)
#define PG8_WAIT_V(n) asm volatile("s_waitcnt vmcnt(" #n ")" ::: "memory")
#define PG8_WAIT_L(n) asm volatile("s_waitcnt lgkmcnt(" #n ")" ::: "memory")
#define PG8_BAR __builtin_amdgcn_s_barrier()
#define PG8_SCHED __builtin_amdgcn_sched_barrier(0)
    Unit cur, nxt; int ui = 0;
    if (!S.next(0, cur)) return;
    Acc acc;
#pragma unroll
    for (int a = 0; a < 2; ++a)
#pragma unroll
        for (int b = 0; b < 2; ++b)
#pragma unroll
            for (int m = 0; m < 4; ++m)
#pragma unroll
                for (int n = 0; n < 2; ++n) acc[a][b][m][n] = (f32x4){0.f, 0.f, 0.f, 0.f};
    bf16x8 At[4][2], B0[2][2], B1[2][2];
    const char* cA = PG8_ABASE(cur); const char* cB = PG8_BBASE(cur);
    PG8_STAGE(PG8_SB(0, 0), cB, voffB); PG8_STAGE(PG8_SB(0, 1), cB + hstepB, voffB); PG8_STAGE(PG8_SA(0, 0), cA, voffA); PG8_STAGE(PG8_SA(0, 1), cA + hstepA, voffA);
    if (wr == 1) PG8_BAR;
    PG8_WAIT_V(2); PG8_BAR;
    PG8_STAGE(PG8_SB(1, 0), cB + kstep, voffB); PG8_STAGE(PG8_SA(1, 0), cA + kstep, voffA); PG8_STAGE(PG8_SB(1, 1), cB + hstepB + kstep, voffB);
    PG8_WAIT_V(6); PG8_BAR;
    for (;;) {
        const bool has_next = S.next(ui + 1, nxt);
        const char* nA = has_next ? PG8_ABASE(nxt) : cA; const char* nB = has_next ? PG8_BBASE(nxt) : cB;
        for (int t = 0; t < nt; t += 2) {
            const bool last = (t == nt - 2);
            const char* a1 = cA + (size_t)(t + 1) * kstep;
            const char* a2 = last ? nA : cA + (size_t)(t + 2) * kstep; const char* b2 = last ? nB : cB + (size_t)(t + 2) * kstep;
            const char* a3 = a2 + kstep; const char* b3 = b2 + kstep;
            PG8_LDB(B0, 0, 0); PG8_LDB(B1, 0, 1); PG8_SCHED; PG8_LDA(At, 0, 0); PG8_STAGE(PG8_SA(1, 1), a1 + hstepA, voffA);
            PG8_WAIT_V(8); PG8_WAIT_L(0); PG8_BAR; PG8_MMA(0, 0, At, B0); PG8_MMA(0, 1, At, B1); PG8_BAR; PG8_SCHED;
            PG8_LDA(At, 0, 1); PG8_STAGE(PG8_SB(0, 0), b2, voffB); PG8_STAGE(PG8_SB(0, 1), b2 + hstepB, voffB); PG8_STAGE(PG8_SA(0, 0), a2, voffA);
            PG8_WAIT_V(8); PG8_WAIT_L(0); PG8_BAR; PG8_MMA(1, 0, At, B0); PG8_MMA(1, 1, At, B1); PG8_BAR; PG8_SCHED;
            PG8_LDB(B0, 1, 0); PG8_LDB(B1, 1, 1); PG8_SCHED; PG8_LDA(At, 1, 0); PG8_STAGE(PG8_SA(0, 1), a2 + hstepA, voffA);
            PG8_WAIT_V(8); PG8_WAIT_L(0); PG8_BAR; PG8_MMA(0, 0, At, B0); PG8_MMA(0, 1, At, B1); PG8_BAR; PG8_SCHED;
            PG8_LDA(At, 1, 1); PG8_STAGE(PG8_SB(1, 0), b3, voffB); PG8_STAGE(PG8_SB(1, 1), b3 + hstepB, voffB); PG8_STAGE(PG8_SA(1, 0), a3, voffA);
            PG8_WAIT_V(8); PG8_WAIT_L(0); PG8_BAR; PG8_MMA(1, 0, At, B0); PG8_MMA(1, 1, At, B1); PG8_BAR; PG8_SCHED;
        }
        if (wr == 0) PG8_BAR;
        E(acc, cur, wr, wc, fr, fq, ui);
        if (!has_next) break;
#pragma unroll
        for (int a = 0; a < 2; ++a)
#pragma unroll
            for (int b = 0; b < 2; ++b)
#pragma unroll
                for (int m = 0; m < 4; ++m)
#pragma unroll
                    for (int n = 0; n < 2; ++n) acc[a][b][m][n] = (f32x4){0.f, 0.f, 0.f, 0.f};
        cur = nxt; cA = nA; cB = nB; ++ui;
        if (wr == 1) PG8_BAR;
    }
    PG8_WAIT_V(0);
    PG8_BAR;
#undef PG8_ABASE
#undef PG8_BBASE
#undef PG8_SA
#undef PG8_SB
#undef PG8_STAGE
#undef PG8_LDA
#undef PG8_LDB
#undef PG8_MMA
#undef PG8_WAIT_V
#undef PG8_WAIT_L
#undef PG8_BAR
#undef PG8_SCHED
}
}

__device__ __forceinline__ void transpose_item(const float* W, int ldw, int k0, int n0, bf16_t* WT, int ldwt, int wrow0, const float* gain, float scale, LAS float* scr, int lane) {
#pragma unroll 8
    for (int i = 0; i < 32; ++i) { const int kk = 2 * i + (lane >> 5); const float gk = gain ? gain[k0 + kk] * scale : scale;
        scr[kk * 33 + (lane & 31)] = W[(size_t)(k0 + kk) * ldw + n0 + (lane & 31)] * gk; }
    LDS_WAIT(); asm volatile("" ::: "memory");
    const int c = lane & 7;
#pragma unroll
    for (int j = 0; j < 4; ++j) { const int n = (lane >> 3) + 8 * j; const LAS float* s = scr + (8 * c) * 33 + n;
        u32x4 o; o.x = pk2(s[0 * 33], s[1 * 33]); o.y = pk2(s[2 * 33], s[3 * 33]); o.z = pk2(s[4 * 33], s[5 * 33]); o.w = pk2(s[6 * 33], s[7 * 33]);
        *(u32x4*)(WT + (size_t)(wrow0 + n) * ldwt + k0 + 8 * c) = o; }
    LDS_WAIT(); asm volatile("" ::: "memory");
}
__device__ __forceinline__ void fourier_fold_item(const float* w_in, const float* gain, bf16_t* Win_t, int item, int lane) {
    const int h = item >> 7, k0 = (item & 127) * 8;
    float w[8], ar[8], ai[8];
#pragma unroll
    for (int kk = 0; kk < 8; ++kk) { w[kk] = w_in[(size_t)(k0 + kk) * 1536 + 1280 + h * 64 + lane] * gain[k0 + kk]; ar[kk] = 0.f; ai[kk] = 0.f; }
#pragma unroll 1
    for (int c = 0; c < 64; ++c) { float sn, cs; sincospif((float)((lane * c) & 63) * (1.0f / 32.0f), &sn, &cs);
#pragma unroll
        for (int kk = 0; kk < 8; ++kk) { const float wv = __builtin_bit_cast(float, __builtin_amdgcn_readlane(__builtin_bit_cast(int, w[kk]), c)); ar[kk] += wv * cs; ai[kk] -= wv * sn; } }
    u32x4 o; o.x = pk2(ar[0] * 0.125f, ar[1] * 0.125f); o.y = pk2(ar[2] * 0.125f, ar[3] * 0.125f); o.z = pk2(ar[4] * 0.125f, ar[5] * 0.125f); o.w = pk2(ar[6] * 0.125f, ar[7] * 0.125f);
    *(u32x4*)(Win_t + (size_t)(1280 + h * 64 + lane) * 1024 + k0) = o;
    o.x = pk2(ai[0] * 0.125f, ai[1] * 0.125f); o.y = pk2(ai[2] * 0.125f, ai[3] * 0.125f); o.z = pk2(ai[4] * 0.125f, ai[5] * 0.125f); o.w = pk2(ai[6] * 0.125f, ai[7] * 0.125f);
    *(u32x4*)(Win_t + (size_t)(1536 + h * 64 + lane) * 1024 + k0) = o;
}
__device__ __forceinline__ void outfold_item(const float* Wsm, const float* sc, const float* w_out, int base, bf16_t* Wout_t, int item, int lane) {
    const int G = item >> 7, n0 = (item & 127) * 8;
    const float* wr_ = Wsm + ((size_t)G * 64 + lane) * 64;
    float acc[8];
#pragma unroll
    for (int i = 0; i < 8; ++i) acc[i] = 0.f;
#pragma unroll 1
    for (int d4 = 0; d4 < 16; ++d4) { const f32x4 wv = *(const f32x4*)(wr_ + 4 * d4);
#pragma unroll
        for (int e = 0; e < 4; ++e) { const int d = 4 * d4 + e; const float s = sc ? sc[G * 64 + d] : 1.f; const float* vr = w_out + (size_t)(base + G * 64 + d) * 1024 + n0;
            const f32x4 v0 = *(const f32x4*)vr, v1 = *(const f32x4*)(vr + 4); const float ws = wv[e] * s;
#pragma unroll
            for (int i = 0; i < 4; ++i) { acc[i] += ws * v0[i]; acc[4 + i] += ws * v1[i]; } } }
#pragma unroll
    for (int i = 0; i < 8; ++i) Wout_t[(size_t)(n0 + i) * 1024 + base + G * 64 + lane] = (bf16_t)f2bf(acc[i]);
}
__device__ __forceinline__ void row_to_bf16_rs(const float* xrow, bf16_t* orow, float* rs_out, int lane) {
    const f32x4* xr = (const f32x4*)xrow + lane;
    f32x4 v[4]; float s = 0.f;
#pragma unroll
    for (int j = 0; j < 4; ++j) { v[j] = xr[64 * j]; s += (v[j].x * v[j].x + v[j].y * v[j].y) + (v[j].z * v[j].z + v[j].w * v[j].w); }
    s = wave_sum(s);
    if (lane == 0) *rs_out = 1.0f / sqrtf(s * (1.f / DM) + RMS_EPS);
    u32x2* o8 = (u32x2*)orow + lane;
#pragma unroll
    for (int j = 0; j < 4; ++j) { u32x2 w; w.x = pk2(v[j].x, v[j].y); w.y = pk2(v[j].z, v[j].w); o8[64 * j] = w; }
}

__device__ __forceinline__ void residual_rows(const float* xin, float* xout, const bf16_t* y, const float* gpost, bf16_t* xb, float* rs, bool write_next, int gw, int NGW, int lane) {
    for (int row = gw; row < MT; row += NGW) {
        const u32x4* yr = (const u32x4*)(y + (size_t)row * DM);
        const u32x4 ya = yr[lane], yb = yr[lane + 64];
        float yv[16];
        yv[0] = bflo(ya.x); yv[1] = bfhi(ya.x); yv[2] = bflo(ya.y); yv[3] = bfhi(ya.y); yv[4] = bflo(ya.z); yv[5] = bfhi(ya.z); yv[6] = bflo(ya.w); yv[7] = bfhi(ya.w);
        yv[8] = bflo(yb.x); yv[9] = bfhi(yb.x); yv[10] = bflo(yb.y); yv[11] = bfhi(yb.y); yv[12] = bflo(yb.z); yv[13] = bfhi(yb.z); yv[14] = bflo(yb.w); yv[15] = bfhi(yb.w);
        float ss = 0.f;
#pragma unroll
        for (int i = 0; i < 16; ++i) ss += yv[i] * yv[i];
        ss = wave_sum(ss);
        const float r = 1.0f / sqrtf(ss * (1.f / DM) + RMS_EPS);
        const f32x4* xr = (const f32x4*)(xin + (size_t)row * DM); const f32x4* gr = (const f32x4*)gpost;
        f32x4 xv[4];
        float ss2 = 0.f;
#pragma unroll
        for (int q = 0; q < 4; ++q) { const int idx = (q >> 1) * 128 + 2 * lane + (q & 1); const f32x4 x4 = xr[idx], g4 = gr[idx];
#pragma unroll
            for (int i = 0; i < 4; ++i) { const float v = x4[i] + yv[q * 4 + i] * r * g4[i]; xv[q][i] = v; ss2 += v * v; } }
        f32x4* xo = (f32x4*)(xout + (size_t)row * DM);
#pragma unroll
        for (int q = 0; q < 4; ++q) xo[(q >> 1) * 128 + 2 * lane + (q & 1)] = xv[q];
        if (write_next) {
            ss2 = wave_sum(ss2);
            if (lane == 0) rs[row] = 1.0f / sqrtf(ss2 * (1.f / DM) + RMS_EPS);
            u32x4* bo = (u32x4*)(xb + (size_t)row * DM);
            u32x4 w; w.x = pk2(xv[0][0], xv[0][1]); w.y = pk2(xv[0][2], xv[0][3]); w.z = pk2(xv[1][0], xv[1][1]); w.w = pk2(xv[1][2], xv[1][3]); bo[lane] = w;
            w.x = pk2(xv[2][0], xv[2][1]); w.y = pk2(xv[2][2], xv[2][3]); w.z = pk2(xv[3][0], xv[3][1]); w.w = pk2(xv[3][2], xv[3][3]); bo[lane + 64] = w;
        }
    }
}
__device__ __forceinline__ void pool_items(const bf16_t* z, bf16_t* cat, int gtid, int NT) {
    for (int idx = gtid; idx < MT * 32; idx += NT) {
        const int token = idx >> 5, c8 = idx & 31, ch = c8 * 8, g = c8 >> 3, win = 2 << g, left = win >> 1, right = win - 1 - left;
        const int t = token & (SEQ - 1), base = token - t;
        const int lo = (t - left) < 0 ? 0 : (t - left), hi = (t + right) > (SEQ - 1) ? (SEQ - 1) : (t + right);
        float sum[8];
#pragma unroll
        for (int i = 0; i < 8; ++i) sum[i] = 0.f;
        for (int r = lo; r <= hi; ++r) { const u32x4 v = *(const u32x4*)(z + (size_t)(base + r) * NZ + ch);
            sum[0] += bflo(v.x); sum[1] += bfhi(v.x); sum[2] += bflo(v.y); sum[3] += bfhi(v.y); sum[4] += bflo(v.z); sum[5] += bfhi(v.z); sum[6] += bflo(v.w); sum[7] += bfhi(v.w); }
        const u32x4 o = *(const u32x4*)(z + (size_t)token * NZ + ch);
        const float inv = 1.0f / (float)(hi - lo + 1);
        u32x4 w;
        w.x = pk2(sum[0] * inv - bflo(o.x), sum[1] * inv - bfhi(o.x)); w.y = pk2(sum[2] * inv - bflo(o.y), sum[3] * inv - bfhi(o.y));
        w.z = pk2(sum[4] * inv - bflo(o.z), sum[5] * inv - bfhi(o.z)); w.w = pk2(sum[6] * inv - bflo(o.w), sum[7] * inv - bfhi(o.w));
        *(u32x4*)(cat + (size_t)token * DM + ch) = w;
    }
}
__device__ __forceinline__ void sgu_chunk(LAS unsigned char* lds, const bf16_t* z, bf16_t* cat, const bf16_t* wsb, const float* gnorm, const float* bias, int chunk, int tid, int wid, int lane) {
    LAS float* stat = (LAS float*)lds;
    LAS bf16_t* vT = (LAS bf16_t*)(lds + 1024);
    const int tok0 = chunk * 128, fr = lane & 15, fq = lane >> 4;
    __syncthreads();
#pragma unroll 4
    for (int i = 0; i < 16; ++i) { const int row = wid * 16 + i;
        const u32x4 v = *(const u32x4*)(z + (size_t)(tok0 + row) * NZ + 768 + lane * 8);
        float x[8]; x[0] = bflo(v.x); x[1] = bfhi(v.x); x[2] = bflo(v.y); x[3] = bfhi(v.y); x[4] = bflo(v.z); x[5] = bfhi(v.z); x[6] = bflo(v.w); x[7] = bfhi(v.w);
        float s = 0.f;
#pragma unroll
        for (int e = 0; e < 8; ++e) s += x[e];
        const float mean = wave_sum(s) * (1.f / 512.f); float q = 0.f;
#pragma unroll
        for (int e = 0; e < 8; ++e) { const float d = x[e] - mean; q += d * d; }
        const float rstd = 1.0f / sqrtf(wave_sum(q) * (1.f / 512.f) + LN_EPS);
        if (lane == 0) { stat[row * 2] = mean; stat[row * 2 + 1] = rstd; } }
    __syncthreads();
    for (int h = 0; h < 4; ++h) {
        if (h) __syncthreads();
#pragma unroll
        for (int it = 0; it < 4; ++it) { const int idx = it * 512 + tid, row = idx >> 4, cb = idx & 15;
            const u32x4 v = *(const u32x4*)(z + (size_t)(tok0 + row) * NZ + 768 + h * 128 + cb * 8);
            const f32x4 g0 = *(const f32x4*)(gnorm + h * 128 + cb * 8), g1 = *(const f32x4*)(gnorm + h * 128 + cb * 8 + 4);
            const float mean = stat[row * 2], rstd = stat[row * 2 + 1];
            LAS bf16_t* d = vT + (cb * 8) * 136 + row;
            d[0 * 136] = (bf16_t)f2bf((bflo(v.x) - mean) * rstd * g0[0]); d[1 * 136] = (bf16_t)f2bf((bfhi(v.x) - mean) * rstd * g0[1]);
            d[2 * 136] = (bf16_t)f2bf((bflo(v.y) - mean) * rstd * g0[2]); d[3 * 136] = (bf16_t)f2bf((bfhi(v.y) - mean) * rstd * g0[3]);
            d[4 * 136] = (bf16_t)f2bf((bflo(v.z) - mean) * rstd * g1[0]); d[5 * 136] = (bf16_t)f2bf((bfhi(v.z) - mean) * rstd * g1[1]);
            d[6 * 136] = (bf16_t)f2bf((bflo(v.w) - mean) * rstd * g1[2]); d[7 * 136] = (bf16_t)f2bf((bfhi(v.w) - mean) * rstd * g1[3]); }
        __syncthreads();
        bf16x8 Y[4];
#pragma unroll
        for (int kk = 0; kk < 4; ++kk) Y[kk] = *(const bf16x8*)(wsb + ((size_t)(h * 128 + wid * 16 + fr)) * 128 + kk * 32 + fq * 8);
        const int token = tok0 + wid * 16 + fr; const float bs = bias[h * 128 + wid * 16 + fr];
#pragma unroll
        for (int cb = 0; cb < 8; ++cb) { f32x4 a = (f32x4){0.f, 0.f, 0.f, 0.f};
#pragma unroll
            for (int kk = 0; kk < 4; ++kk) { const bf16x8 X = *(const LAS bf16x8*)(vT + (cb * 16 + fr) * 136 + kk * 32 + fq * 8); a = __builtin_amdgcn_mfma_f32_16x16x32_bf16(X, Y[kk], a, 0, 0, 0); }
            const int ch = h * 128 + cb * 16 + 4 * fq;
            const u32x2 uu = *(const u32x2*)(z + (size_t)token * NZ + 256 + ch);
            u32x2 w; w.x = pk2(bflo(uu.x) * (a[0] + bs), bfhi(uu.x) * (a[1] + bs)); w.y = pk2(bflo(uu.y) * (a[2] + bs), bfhi(uu.y) * (a[3] + bs));
            *(u32x2*)(cat + (size_t)token * DM + 256 + ch) = w; }
    }
}
__device__ __forceinline__ void t1_job(LAS unsigned char* lds, const bf16_t* z, bf16_t* A1, int job, int tid, int wid, int lane) {
    const int b = job >> 7, s2 = job & 127;
    LAS unsigned* tile = (LAS unsigned*)lds;
    __syncthreads();
#pragma unroll
    for (int i = 0; i < 8; ++i) { const int s1 = wid * 8 + i;
        const u32x4 v = *(const u32x4*)(z + (size_t)(b * SEQ + 128 * s1 + s2) * NZ + 1280 + lane * 8);
        LAS unsigned* d = tile + s1 * 257 + lane * 4; d[0] = v.x; d[1] = v.y; d[2] = v.z; d[3] = v.w; }
    __syncthreads();
    const LAS unsigned short* t16 = (const LAS unsigned short*)lds;
#pragma unroll
    for (int it = 0; it < 8; ++it) { const int idx = it * 512 + tid, s1b = idx & 7, ri = (idx >> 3) & 1, c = idx >> 4;
        const LAS unsigned short* s = t16 + (s1b * 8) * 514 + ri * 256 + c;
        u32x4 w; w.x = (unsigned)s[0 * 514] | ((unsigned)s[1 * 514] << 16); w.y = (unsigned)s[2 * 514] | ((unsigned)s[3 * 514] << 16);
        w.z = (unsigned)s[4 * 514] | ((unsigned)s[5 * 514] << 16); w.w = (unsigned)s[6 * 514] | ((unsigned)s[7 * 514] << 16);
        *(u32x4*)(A1 + ((size_t)((b * 256 + c) * 128 + s2)) * 128 + ri * 64 + s1b * 8) = w; }
}

struct Args { const float* in[24]; float* out; unsigned char* ws; int ph_lo, ph_hi; };
constexpr int PH_PER_LAYER = 14, N_PHASES = 1 + NL * PH_PER_LAYER;

__global__ void __launch_bounds__(512, 2) enc_fwd(Args args) {
    extern __shared__ __attribute__((aligned(16))) unsigned char lds_raw[];
    LAS unsigned char* lds = (LAS unsigned char*)lds_raw;
    cg::grid_group grid = cg::this_grid();
    const int G = gridDim.x, bid = blockIdx.x, NGW = G * 8, NT = G * 512;
#define TID_BEGIN int tid = threadIdx.x; asm volatile("" : "+v"(tid)); const int lane = tid & 63, wid = __builtin_amdgcn_readfirstlane(tid >> 6), gw = bid * 8 + wid, gtid = bid * 512 + tid; (void)gw; (void)gtid; (void)lane
    unsigned char* ws = args.ws;
    const int lo = args.ph_lo, hi = args.ph_hi;
#define IN(k) (lo <= (k) && (k) < hi)
#define SEAM(k) do { if (IN(k) && IN((k) + 1)) grid.sync(); } while (0)

#define PH_BEGIN(lv) unsigned char* W = ws; int L = (lv); asm volatile("" : "+s"(W), "+s"(L))
#define PB(off) ((bf16_t*)(W + (off)))
#define PF(off) ((float*)(W + (off)))
#define WLP(off) ((bf16_t*)(W + WS_W + (size_t)L * W_LAYER + (off)))
    if (IN(0) && DBG(0)) {
        PH_BEGIN(0); TID_BEGIN;
        bf16_t* F1 = PB(WS_F1); bf16_t* F2 = PB(WS_F2); float* twc = PF(WS_TWC); float* tws = PF(WS_TWS); float* rsmem = PF(WS_RSMEM); float* rs = PF(WS_RS);
        bf16_t* memb = PB(WS_MEMB); bf16_t* xb = PB(WS_XB);
        LAS float* scr = (LAS float*)(lds + wid * 16384);
        constexpr int I_FF = 512, I_OF = 1024, I_TR = 7168, I_SG = 128, I_LAYER = I_FF + I_OF + I_TR + I_SG;
        constexpr int I_F1 = 64, I_F2 = 128, I_TW = 16, I_GLOB = I_F1 + I_F2 + I_TW;
        constexpr int NITEMS = NL * I_LAYER + I_GLOB;
        for (int it = gw; it < NITEMS; it += NGW) {
            int r = it;
            if (r >= NL * I_LAYER) {
                r -= NL * I_LAYER;
                if (r < I_F1) {
#pragma unroll 1
                    for (int e = 0; e < 8; ++e) { const int idx = r * 512 + e * 64 + lane, row = idx >> 7, col = idx & 127, ro = row >> 7, k1 = row & 127, ri = col >> 6, s1 = col & 63;
                        float sn, cs; sincospif((float)((k1 * s1) & 63) * (1.0f / 32.0f), &sn, &cs);
                        float v = (ro == ri) ? cs : (ro == 0 ? sn : -sn); if (k1 >= 64) v = 0.f;
                        F1[idx] = (bf16_t)f2bf(v * 0.125f); }
                } else if (r < I_F1 + I_F2) {
                    r -= I_F1;
#pragma unroll 1
                    for (int e = 0; e < 8; ++e) { const int idx = r * 512 + e * 64 + lane, row = idx >> 8, col = idx & 255, ri = col >> 7, s2 = col & 127;
                        float sn, cs; sincospif((float)((row * s2) & 127) * (1.0f / 64.0f), &sn, &cs);
                        float v = ri ? sn : cs; if (row >= 128) v = 0.f;
                        F2[idx] = (bf16_t)f2bf(v * 0.08838834764831845f); }
                } else {
                    r -= I_F1 + I_F2;
#pragma unroll 1
                    for (int e = 0; e < 8; ++e) { const int idx = r * 512 + e * 64 + lane, k1 = idx >> 7, s2 = idx & 127;
                        float sn, cs; sincospif((float)(k1 * s2) * (1.0f / 4096.0f), &sn, &cs); twc[idx] = cs; tws[idx] = sn; }
                }
                continue;
            }
            const int l = r / I_LAYER; r -= l * I_LAYER;
            unsigned char* wl = ws + WS_W + (size_t)l * W_LAYER;
            bf16_t* Win_t = (bf16_t*)(wl + W_IN); bf16_t* Wout_t = (bf16_t*)(wl + W_OUT);
            const float* w_in = args.in[3] + (size_t)l * 1024 * 1536; const float* w_out = args.in[10] + (size_t)l * 1024 * 1024;
            if (r < I_FF) { fourier_fold_item(w_in, args.in[2] + l * 1024, Win_t, r, lane); continue; } r -= I_FF;
            if (r < I_OF) {
                if (r < 512) outfold_item(args.in[4] + (size_t)l * 4 * 64 * 64, args.in[5] + l * 256, w_out, 0, Wout_t, r, lane);
                else outfold_item(args.in[9] + (size_t)l * 4 * 64 * 64, nullptr, w_out, 768, Wout_t, r - 512, lane);
                continue; } r -= I_OF;
            if (r < I_TR) {
                if (r < 640) { transpose_item(w_in, 1536, 64 * (r / 40), 32 * (r % 40), Win_t, 1024, 32 * (r % 40), args.in[2] + l * 1024, 1.f, scr, lane); continue; } r -= 640;
                if (r < 256) { transpose_item(w_out, 1024, 256 + 64 * (r / 32), 32 * (r % 32), Wout_t, 1024, 32 * (r % 32), nullptr, 1.f, scr, lane); continue; } r -= 256;
                if (r < 2048) { const int which = r >> 9, rr = r & 511;
                    const float* W = args.in[14 + which] + (size_t)l * 1024 * 1024;
                    const float* gn = which == 0 ? args.in[12] + l * 1024 : (which == 3 ? nullptr : args.in[13] + l * 1024);
                    transpose_item(W, 1024, 64 * (rr / 32), 32 * (rr % 32), (bf16_t*)(wl + W_Q + (size_t)which * 2 * MiB), 1024, 32 * (rr % 32), gn, which == 0 ? 0.0625f : 1.f, scr, lane); continue; } r -= 2048;
                if (r < 2816) { const int which = r / 1408, rr = r % 1408, n0 = 32 * (rr % 88);
                    transpose_item(args.in[20 + which] + (size_t)l * 1024 * FF, FF, 64 * (rr / 88), n0, (bf16_t*)(wl + W_GU), 1024, (n0 >> 7) * 256 + which * 128 + (n0 & 127), args.in[19] + l * 1024, 1.f, scr, lane); continue; } r -= 2816;
                transpose_item(args.in[22] + (size_t)l * FF * 1024, 1024, 64 * (r / 32), 32 * (r % 32), (bf16_t*)(wl + W_D), FF, 32 * (r % 32), nullptr, 1.f, scr, lane);
                continue; } r -= I_TR;
            {
                const float* src = args.in[7] + (size_t)l * 65536 + r * 512 + lane * 8; bf16_t* dst = (bf16_t*)(wl + W_SGU) + r * 512 + lane * 8;
                const f32x4 a = *(const f32x4*)src, b = *(const f32x4*)(src + 4);
                u32x4 w; w.x = pk2(a[0], a[1]); w.y = pk2(a[2], a[3]); w.z = pk2(b[0], b[1]); w.w = pk2(b[2], b[3]); *(u32x4*)dst = w;
            }
        }
        for (int m = gw; m < MROWS; m += NGW) row_to_bf16_rs(args.in[1] + (size_t)m * DM, memb + (size_t)m * DM, rsmem + m, lane);
        for (int m = gw; m < MT; m += NGW) row_to_bf16_rs(args.in[0] + (size_t)m * DM, xb + (size_t)m * DM, rs + m, lane);
    }
    SEAM(0);

#pragma unroll 1
    for (int l = 0; l < NL; ++l) {
        const int p0 = 1 + l * PH_PER_LAYER;
        if (IN(p0 + 0)) {
            if (DBG(1)) { PH_BEGIN(l); pg8::Gemm g = pg8::mk_gemm(PB(WS_XB), DM, WLP(W_IN), DM, DM, MT / 256, NZ / 256); pg8::StaticOrder S; S.init(g.nM, g.nN, G, bid);
              pg8::EpiRow E{PB(WS_R + R_Z), NZ, PF(WS_RS)}; pg8::gemm_phase(lds, g, S, E); }
            if (l == 0 && DBG(2)) {
#pragma unroll 1
                for (int l2 = 0; l2 < NL; ++l2) {
                    { PH_BEGIN(l2); pg8::Gemm g = pg8::mk_gemm(PB(WS_MEMB), DM, WLP(W_K), DM, DM, 4, 4); pg8::StaticOrder S; S.init(4, 4, G, (bid + G - (128 + 32 * l2) % G) % G);
                      pg8::EpiRow E{PB(WS_KB) + (size_t)L * MROWS * DM, DM, PF(WS_RSMEM)}; pg8::gemm_phase(lds, g, S, E); }
                    { PH_BEGIN(l2); pg8::Gemm g = pg8::mk_gemm(WLP(W_V), DM, PB(WS_MEMB), DM, DM, 4, 4); pg8::StaticOrder S; S.init(4, 4, G, (bid + G - (144 + 32 * l2) % G) % G);
                      pg8::EpiCol E{PB(WS_VT) + (size_t)L * MROWS * DM, DM, PF(WS_RSMEM)}; pg8::gemm_phase(lds, g, S, E); }
                }
            }
        }
        SEAM(p0 + 0);
        if (IN(p0 + 1) && DBG(3)) {
            PH_BEGIN(l); TID_BEGIN;
            const bf16_t* zb = PB(WS_R + R_Z); bf16_t* cat = PB(WS_R + R_CAT);
            for (int j = bid; j < 512; j += G) t1_job(lds, zb, PB(WS_R + R_A1), j, tid, wid, lane);
            for (int j = bid; j < 256; j += G) sgu_chunk(lds, zb, cat, WLP(W_SGU), args.in[6] + L * 512, args.in[8] + L * 512, j, tid, wid, lane);
            pool_items(zb, cat, gtid, NT);
            __syncthreads();
        }
        SEAM(p0 + 1);
        if (IN(p0 + 2) && DBG(4)) {
            PH_BEGIN(l);
            pg8::Gemm g = pg8::mk_gemm(PB(WS_F1), 128, PB(WS_R + R_A1), 128, 128, 1, 512); pg8::StaticOrder S; S.init(1, 512, G, bid);
            pg8::EpiFFT1 E{PB(WS_R + R_A2), PF(WS_TWC), PF(WS_TWS)}; pg8::gemm_phase(lds, g, S, E);
        }
        SEAM(p0 + 2);
        if (IN(p0 + 3) && DBG(5)) {
            PH_BEGIN(l);
            pg8::Gemm g = pg8::mk_gemm(PB(WS_F2), 256, PB(WS_R + R_A2), 256, 256, 1, 256); pg8::StaticOrder S; S.init(1, 256, G, bid);
            pg8::EpiFFT2 E{PB(WS_R + R_CAT)}; pg8::gemm_phase(lds, g, S, E);
        }
        SEAM(p0 + 3);
        if (IN(p0 + 4) && DBG(6)) {
            PH_BEGIN(l);
            pg8::Gemm g = pg8::mk_gemm(PB(WS_R + R_CAT), DM, WLP(W_OUT), DM, DM, MT / 256, 4); pg8::StaticOrder S; S.init(g.nM, g.nN, G, bid);
            pg8::EpiRow E{PB(WS_Y), DM, nullptr}; pg8::gemm_phase(lds, g, S, E);
        }
        SEAM(p0 + 4);
        if (IN(p0 + 5) && DBG(7)) { PH_BEGIN(l); TID_BEGIN; residual_rows(L == 0 ? args.in[0] : args.out, args.out, PB(WS_Y), args.in[11] + L * 1024, PB(WS_XB), PF(WS_RS), true, gw, NGW, lane); }
        SEAM(p0 + 5);
        if (IN(p0 + 6) && DBG(8)) {
            PH_BEGIN(l);
            pg8::Gemm g = pg8::mk_gemm(PB(WS_XB), DM, WLP(W_Q), DM, DM, MT / 256, 4); pg8::StaticOrder S; S.init(g.nM, g.nN, G, bid);
            pg8::EpiRow E{PB(WS_R + R_Q), DM, PF(WS_RS)}; pg8::gemm_phase(lds, g, S, E);
        }
        SEAM(p0 + 6);
        if (IN(p0 + 7) && DBG(9)) {
            PH_BEGIN(l);
            pg8::Gemm g = pg8::mk_gemm(PB(WS_R + R_Q), DM, PB(WS_KB) + (size_t)L * MROWS * DM, DM, 256, MT / 256, 4); g.a_pn = 512; g.b_pn = 512; g.b_pq = 512L * DM; g.b_div = 32;
            pg8::StaticOrder S; S.init(g.nM, g.nN, G, bid);
            pg8::EpiSoftmax E{PB(WS_R + R_P), DM, lds + XCH_OFF}; pg8::gemm_phase(lds, g, S, E);
        }
        SEAM(p0 + 7);
        if (IN(p0 + 8) && DBG(10)) {
            PH_BEGIN(l);
            pg8::Gemm g = pg8::mk_gemm(PB(WS_R + R_P), DM, PB(WS_VT) + (size_t)L * MROWS * DM, DM, 256, MT / 256, 4); g.a_pn = 512; g.b_pn = 512L * DM; g.b_pq = 512; g.b_div = 32;
            pg8::StaticOrder S; S.init(g.nM, g.nN, G, bid);
            pg8::EpiRow E{PB(WS_R + R_Q), DM, nullptr}; pg8::gemm_phase(lds, g, S, E);
        }
        SEAM(p0 + 8);
        if (IN(p0 + 9) && DBG(11)) {
            PH_BEGIN(l);
            pg8::Gemm g = pg8::mk_gemm(PB(WS_R + R_Q), DM, WLP(W_O), DM, DM, MT / 256, 4); pg8::StaticOrder S; S.init(g.nM, g.nN, G, bid);
            pg8::EpiRow E{PB(WS_Y), DM, nullptr}; pg8::gemm_phase(lds, g, S, E);
        }
        SEAM(p0 + 9);
        if (IN(p0 + 10) && DBG(7)) { PH_BEGIN(l); TID_BEGIN; residual_rows(args.out, args.out, PB(WS_Y), args.in[18] + L * 1024, PB(WS_XB), PF(WS_RS), true, gw, NGW, lane); }
        SEAM(p0 + 10);
        if (IN(p0 + 11) && DBG(12)) {
            PH_BEGIN(l);
            pg8::Gemm g = pg8::mk_gemm(PB(WS_XB), DM, WLP(W_GU), DM, DM, MT / 256, FF2 / 256); pg8::StaticOrder S; S.init(g.nM, g.nN, G, bid);
            pg8::EpiSwiGLU E{PB(WS_R + R_ACT), FF, PF(WS_RS)}; pg8::gemm_phase(lds, g, S, E);
        }
        SEAM(p0 + 11);
        if (IN(p0 + 12) && DBG(13)) {
            PH_BEGIN(l);
            pg8::Gemm g = pg8::mk_gemm(PB(WS_R + R_ACT), FF, WLP(W_D), FF, FF, MT / 256, 4); pg8::StaticOrder S; S.init(g.nM, g.nN, G, bid);
            pg8::EpiRow E{PB(WS_Y), DM, nullptr}; pg8::gemm_phase(lds, g, S, E);
        }
        SEAM(p0 + 12);
        if (IN(p0 + 13) && DBG(7)) { PH_BEGIN(l); TID_BEGIN; residual_rows(args.out, args.out, PB(WS_Y), args.in[23] + L * 1024, PB(WS_XB), PF(WS_RS), L + 1 < NL, gw, NGW, lane); }
        SEAM(p0 + 13);
    }
#undef IN
#undef SEAM
}

extern "C" void kernel_launch(void* const* d_in, const int* in_sizes, int n_in, void* d_out, int out_size, void* d_ws, size_t ws_size, hipStream_t stream) {
    static int grid = 0;
    if (grid == 0) {
        if (n_in != 24 || in_sizes[0] != MT * DM || out_size != MT * DM || ws_size < WS_END) { fprintf(stderr, "kernel_launch: unexpected shapes (n_in %d, ws %zu)\n", n_in, ws_size); grid = -1; return; }
        int dev = 0, cus = 0, per_cu = 0;
        if (hipGetDevice(&dev) != hipSuccess || hipDeviceGetAttribute(&cus, hipDeviceAttributeMultiprocessorCount, dev) != hipSuccess) { grid = -1; return; }
        if (hipFuncSetAttribute((const void*)enc_fwd, hipFuncAttributeMaxDynamicSharedMemorySize, LDS_BYTES) != hipSuccess) { fprintf(stderr, "kernel_launch: hipFuncSetAttribute failed\n"); grid = -1; return; }
        if (hipOccupancyMaxActiveBlocksPerMultiprocessor(&per_cu, (const void*)enc_fwd, 512, LDS_BYTES) != hipSuccess || per_cu < 1) { fprintf(stderr, "kernel_launch: occupancy query gives %d\n", per_cu); (void)hipGetLastError(); grid = -1; return; }
        grid = cus * per_cu;
    }
    if (grid < 0) return;
    Args a{};
    for (int i = 0; i < 24; ++i) a.in[i] = (const float*)d_in[i];
    a.out = (float*)d_out; a.ws = (unsigned char*)d_ws;
#if MK_PER_PHASE
    for (int p = 0; p < N_PHASES; ++p) { a.ph_lo = p; a.ph_hi = p + 1; hipLaunchKernelGGL(enc_fwd, dim3(grid), dim3(512), LDS_BYTES, stream, a); }
#else
    a.ph_lo = 0; a.ph_hi = N_PHASES;
    void* kargs[] = {&a};
    hipError_t e = hipLaunchCooperativeKernel((const void*)enc_fwd, dim3(grid), dim3(512), kargs, LDS_BYTES, stream);
    if (e != hipSuccess) fprintf(stderr, "kernel_launch: cooperative launch failed: %s (grid %d)\n", hipGetErrorString(e), grid);
#endif
}
```

```cpp
#include <hip/hip_runtime.h>
#include <hip/hip_cooperative_groups.h>
#include <cstdio>
#include <cstdint>
namespace cg = cooperative_groups;

#ifndef MK_PER_PHASE
#define MK_PER_PHASE 0
#endif

#ifndef DBG_MASK
#define DBG_MASK 0xFFFFFFFFu
#endif
#define DBG(b) ((DBG_MASK >> (b)) & 1u)
#ifndef REP_MASK
#define REP_MASK 0u
#endif
#define REPS(b) (int)(((REP_MASK >> (b)) & 1u) + 1u)
#define REPEAT(b) _Pragma("unroll 1") for (int rep_ = 0; rep_ < REPS(b); ++rep_)
#define LAS __attribute__((address_space(3)))
typedef unsigned short bf16_t;
typedef short bf16x8 __attribute__((ext_vector_type(8)));
typedef float f32x4 __attribute__((ext_vector_type(4)));
typedef float f32x2 __attribute__((ext_vector_type(2)));
typedef unsigned u32x4 __attribute__((ext_vector_type(4)));
typedef unsigned u32x2 __attribute__((ext_vector_type(2)));

constexpr int NB = 4, SEQ = 8192, DM = 1024, MT = NB * SEQ, NL = 2;
constexpr int NZ = 1792;
constexpr int FF = 2816, FF2 = 5632;
constexpr int MROWS = 1024;
constexpr float RMS_EPS = 1e-6f, LN_EPS = 1e-5f;

constexpr size_t MiB = 1u << 20;
constexpr size_t WS_F1 = 0, WS_F2 = 64 * 1024, WS_TWC = 192 * 1024, WS_TWS = 224 * 1024, WS_RSMEM = 256 * 1024;
constexpr size_t WS_RS = 1 * MiB, WS_MEMB = 2 * MiB, WS_KB = 4 * MiB, WS_VT = 8 * MiB;
constexpr size_t WS_W = 16 * MiB, W_LAYER = 32 * MiB;
constexpr size_t W_IN = 0, W_OUT = 4 * MiB, W_Q = 6 * MiB, W_K = 8 * MiB, W_V = 10 * MiB, W_O = 12 * MiB, W_GU = 14 * MiB, W_D = 25 * MiB, W_SGU = 31 * MiB;
constexpr size_t WS_XB = 80 * MiB, WS_Y = 144 * MiB, WS_R = 208 * MiB;
constexpr size_t R_Z = 0, R_CAT = 112 * MiB, R_A1 = 176 * MiB, R_A2 = 208 * MiB;
constexpr size_t R_Q = 0, R_P = 64 * MiB;
constexpr size_t R_ACT = 0;
constexpr size_t WS_END = 448 * MiB;

constexpr int XCH_OFF = 131072, MISC_OFF = XCH_OFF + 16384;
constexpr int LDS_BYTES = MISC_OFF + 256;
constexpr size_t WS_BAR = 320 * 1024;

__device__ __forceinline__ unsigned f2bf(float f) { unsigned u = __builtin_bit_cast(unsigned, f); return (u + 0x7fffu + ((u >> 16) & 1u)) >> 16; }
__device__ __forceinline__ unsigned pk2(float lo, float hi) { return f2bf(lo) | (f2bf(hi) << 16); }
__device__ __forceinline__ float bflo(unsigned w) { return __builtin_bit_cast(float, w << 16); }
__device__ __forceinline__ float bfhi(unsigned w) { return __builtin_bit_cast(float, w & 0xffff0000u); }
__device__ __forceinline__ unsigned cvt_pk_bf16(float lo, float hi) { unsigned r; asm volatile("v_cvt_pk_bf16_f32 %0, %1, %2" : "=v"(r) : "v"(lo), "v"(hi)); return r; }
__device__ __forceinline__ float wave_sum(float v) {
#pragma unroll
    for (int o = 1; o < 64; o <<= 1) v += __shfl_xor(v, o);
    return v;
}
#define LDS_WAIT() asm volatile("s_waitcnt lgkmcnt(0)" ::: "memory")

namespace pg8 {
#define PG8_LAS __attribute__((address_space(3)))
constexpr int BM = 256, BK = 64, HALF = 128, HTB = HALF * BK * 2  , STAGE_BYTES = 8 * HTB, NXCD = 8, WGM = 8;

__host__ __device__ __forceinline__ int lds_byte(int r, int c) { const int st = (r >> 4) * 2 + (c >> 5), rr = r & 15, cc = c & 31, ob = rr * 64 + cc * 2; return st * 1024 + (ob ^ (((ob >> 9) & 1) << 5)); }
__host__ __device__ __forceinline__ void stage_rc(int b, int& R, int& C) { const int st = b / 1024, sb = b % 1024, swz = sb ^ (((sb >> 9) & 1) << 5); R = (st >> 1) * 16 + swz / 64; C = (st & 1) * 32 + (swz % 64) / 2; }
__host__ __device__ __forceinline__ int perm32(int rho) { const int n = rho >> 4, i = rho & 15; return 8 * (i >> 2) + 4 * n + (i & 3); }

struct Unit { int pm, pn; };
struct Gemm { const bf16_t* A; const bf16_t* Bt; int lda, ldb, K, nM, nN, b_div; long a_pm, a_pn, b_pn, b_pq; };
__device__ __forceinline__ Gemm mk_gemm(const bf16_t* A, int lda, const bf16_t* Bt, int ldb, int K, int nM, int nN) {
    Gemm g; g.A = A; g.Bt = Bt; g.lda = lda; g.ldb = ldb; g.K = K; g.nM = nM; g.nN = nN; g.b_div = 1;
    g.a_pm = 512L * lda; g.a_pn = 0; g.b_pn = 512L * ldb; g.b_pq = 0; return g;
}

struct StaticOrder {
    int nM, nN, nwg, G, c, nrep;
    __host__ __device__ void init(int nM_, int nN_, int G_, int c_, int nrep_ = 1) { nM = nM_; nN = nN_; nwg = nM * nN; G = G_; c = c_; nrep = nrep_; }
    __host__ __device__ bool next(int i, Unit& u) const {
        const long L = (long)i * G + c; if (L >= (long)nwg * nrep) return false;
        int wgid = (int)L; if (nrep > 1 && wgid >= nwg) wgid -= nwg; { const int q = nwg / NXCD, r = nwg % NXCD, xcd = wgid % NXCD, off = wgid / NXCD; wgid = (xcd < r ? xcd * (q + 1) : r * (q + 1) + (xcd - r) * q) + off; }
        const int nig = WGM * nN, gid = wgid / nig, fm = gid * WGM, gsz = (nM - fm) < WGM ? (nM - fm) : WGM;
        u.pm = fm + ((wgid % nig) % gsz); u.pn = (wgid % nig) / gsz; return true;
    }
};

typedef f32x4 Acc[2][2][4][2];

__device__ __forceinline__ u32x4 pack8(f32x4 v0, f32x4 v1) { u32x4 w; w.x = cvt_pk_bf16(v0[0], v0[1]); w.y = cvt_pk_bf16(v0[2], v0[3]); w.z = cvt_pk_bf16(v1[0], v1[1]); w.w = cvt_pk_bf16(v1[2], v1[3]); return w; }

struct EpiRow {
    static constexpr bool PERM = true;
    bf16_t* O; int ldc; const float* rs;
    __device__ __forceinline__ void operator()(Acc& acc, const Unit& u, int wr, int wc, int fr, int fq, int ui) const {
        asm volatile("" : "+v"(fr), "+v"(fq));
        const int row0 = u.pm * BM + wr * 64 + fr, col0 = u.pn * BM + wc * 32 + 8 * fq;
#pragma unroll
        for (int ai = 0; ai < 2; ++ai)
#pragma unroll
            for (int m = 0; m < 4; ++m) { const int row = row0 + ai * HALF + m * 16; const float s = rs ? rs[row] : 1.f; bf16_t* rowp = O + (size_t)row * ldc + col0;
#pragma unroll
                for (int bj = 0; bj < 2; ++bj) *(u32x4*)(rowp + bj * HALF) = pack8(acc[ai][bj][m][0] * s, acc[ai][bj][m][1] * s); }
    }
};
struct EpiCol {
    static constexpr bool PERM = true;
    bf16_t* O; int ldc; const float* cs;
    __device__ __forceinline__ void operator()(Acc& acc, const Unit& u, int wr, int wc, int fr, int fq, int ui) const {
        asm volatile("" : "+v"(fr), "+v"(fq));
        const int row0 = u.pm * BM + wr * 64 + fr, col0 = u.pn * BM + wc * 32 + 8 * fq;
        f32x4 sv[2][2];
#pragma unroll
        for (int bj = 0; bj < 2; ++bj)
#pragma unroll
            for (int n = 0; n < 2; ++n) sv[bj][n] = *(const f32x4*)(cs + col0 + bj * HALF + 4 * n);
#pragma unroll
        for (int ai = 0; ai < 2; ++ai)
#pragma unroll
            for (int m = 0; m < 4; ++m) { const int row = row0 + ai * HALF + m * 16; bf16_t* rowp = O + (size_t)row * ldc + col0;
#pragma unroll
                for (int bj = 0; bj < 2; ++bj) *(u32x4*)(rowp + bj * HALF) = pack8(acc[ai][bj][m][0] * sv[bj][0], acc[ai][bj][m][1] * sv[bj][1]); }
    }
};
struct EpiSwiGLU {
    static constexpr bool PERM = true;
    bf16_t* O; int ldc; const float* rs;
    __device__ __forceinline__ void operator()(Acc& acc, const Unit& u, int wr, int wc, int fr, int fq, int ui) const {
        asm volatile("" : "+v"(fr), "+v"(fq));
        const int row0 = u.pm * BM + wr * 64 + fr, col0 = u.pn * HALF + wc * 32 + 8 * fq;
#pragma unroll
        for (int ai = 0; ai < 2; ++ai)
#pragma unroll
            for (int m = 0; m < 4; ++m) { const int row = row0 + ai * HALF + m * 16; const float s = rs[row];
                f32x4 o[2];
#pragma unroll
                for (int n = 0; n < 2; ++n) { const f32x4 g = acc[ai][0][m][n] * s, up = acc[ai][1][m][n] * s;
#pragma unroll
                    for (int i = 0; i < 4; ++i) o[n][i] = g[i] * __builtin_amdgcn_rcpf(1.f + __expf(-g[i])) * up[i]; }
                *(u32x4*)(O + (size_t)row * ldc + col0) = pack8(o[0], o[1]); }
    }
};
struct EpiSoftmax {
    static constexpr bool PERM = true;
    bf16_t* P; int ldc; PG8_LAS unsigned char* xl;
    __device__ __forceinline__ void operator()(Acc& acc, const Unit& u, int wr, int wc, int fr, int fq, int ui) const {
        asm volatile("" : "+v"(fr), "+v"(fq));
        PG8_LAS f32x2* X = (PG8_LAS f32x2*)(xl + (ui & 1) * 8192);
#pragma unroll
        for (int ai = 0; ai < 2; ++ai)
#pragma unroll
            for (int m = 0; m < 4; ++m) {
                float mx = -3.0e38f;
#pragma unroll
                for (int bj = 0; bj < 2; ++bj)
#pragma unroll
                    for (int n = 0; n < 2; ++n) { const f32x4 v = acc[ai][bj][m][n]; mx = fmaxf(mx, fmaxf(fmaxf(v[0], v[1]), fmaxf(v[2], v[3]))); }
                mx = fmaxf(mx, __shfl_xor(mx, 16)); mx = fmaxf(mx, __shfl_xor(mx, 32));
                float s = 0.f;
#pragma unroll
                for (int bj = 0; bj < 2; ++bj)
#pragma unroll
                    for (int n = 0; n < 2; ++n) { f32x4 v = acc[ai][bj][m][n];
#pragma unroll
                        for (int i = 0; i < 4; ++i) { v[i] = __expf(v[i] - mx); s += v[i]; }
                        acc[ai][bj][m][n] = v; }
                s += __shfl_xor(s, 16); s += __shfl_xor(s, 32);
                if (fq == 0) X[(ai * HALF + wr * 64 + m * 16 + fr) * 4 + wc] = (f32x2){mx, s};
            }
        asm volatile("s_waitcnt lgkmcnt(0)" ::: "memory"); __builtin_amdgcn_s_barrier(); asm volatile("" ::: "memory");
#pragma unroll
        for (int ai = 0; ai < 2; ++ai)
#pragma unroll
            for (int m = 0; m < 4; ++m) { const int r = ai * HALF + wr * 64 + m * 16 + fr;
                const f32x2 e0 = X[r * 4 + 0], e1 = X[r * 4 + 1], e2 = X[r * 4 + 2], e3 = X[r * 4 + 3];
                const float gm = fmaxf(fmaxf(e0.x, e1.x), fmaxf(e2.x, e3.x));
                const float tot = e0.y * __expf(e0.x - gm) + e1.y * __expf(e1.x - gm) + e2.y * __expf(e2.x - gm) + e3.y * __expf(e3.x - gm);
                const float own = wc == 0 ? e0.x : (wc == 1 ? e1.x : (wc == 2 ? e2.x : e3.x));
                const float f = __expf(own - gm) / tot;
                bf16_t* rowp = P + (size_t)(u.pm * BM + r) * ldc + u.pn * BM + wc * 32 + 8 * fq;
#pragma unroll
                for (int bj = 0; bj < 2; ++bj) *(u32x4*)(rowp + bj * HALF) = pack8(acc[ai][bj][m][0] * f, acc[ai][bj][m][1] * f); }
    }
};
struct EpiFFT1 {
    static constexpr bool PERM = true;
    bf16_t* A2; const float* twc_; const float* tws_;
    __device__ __forceinline__ void operator()(Acc& acc, const Unit& u, int wr, int wc, int fr, int fq, int ui) const {
        asm volatile("" : "+v"(fr), "+v"(fq));
        if (wr != 0) return;
        const float* twc = twc_; const float* tws = tws_;
        asm volatile("" : "+s"(twc), "+s"(tws));
        const int s20 = wc * 32 + 8 * fq;
#pragma unroll
        for (int m = 0; m < 4; ++m) { const int k1 = 16 * m + fr;
#pragma unroll
            for (int n = 0; n < 2; ++n) { const f32x4 c4 = *(const f32x4*)(twc + k1 * 128 + s20 + 4 * n), s4 = *(const f32x4*)(tws + k1 * 128 + s20 + 4 * n);
#pragma unroll
                for (int bj = 0; bj < 2; ++bj) { const f32x4 tr = acc[0][bj][m][n], ti = acc[1][bj][m][n]; acc[0][bj][m][n] = tr * c4 + ti * s4; acc[1][bj][m][n] = ti * c4 - tr * s4; } }
#pragma unroll
            for (int bj = 0; bj < 2; ++bj) { const int bc = u.pn * 2 + bj, b = bc >> 8, c = bc & 255;
                bf16_t* dst = A2 + ((size_t)((b * 64 + k1) * 256 + c)) * 256 + s20;
                *(u32x4*)dst = pack8(acc[0][bj][m][0], acc[0][bj][m][1]);
                *(u32x4*)(dst + 128) = pack8(acc[1][bj][m][0], acc[1][bj][m][1]); }
            asm volatile("" ::: "memory"); }
    }
};
struct EpiFFT2 {
    static constexpr bool PERM = true;
    bf16_t* cat;
    __device__ __forceinline__ void operator()(Acc& acc, const Unit& u, int wr, int wc, int fr, int fq, int ui) const {
        asm volatile("" : "+v"(fr), "+v"(fq));
        const int b = u.pn >> 6, k1 = u.pn & 63;
#pragma unroll
        for (int m = 0; m < 4; ++m) { const int k2 = 64 * wr + 16 * m + fr; const size_t token = (size_t)b * SEQ + k1 + 64 * k2;
            bf16_t* rowp = cat + token * DM + 768 + wc * 32 + 8 * fq;
#pragma unroll
            for (int bj = 0; bj < 2; ++bj) *(u32x4*)(rowp + bj * HALF) = pack8(acc[0][bj][m][0], acc[0][bj][m][1]); }
    }
};

template <class Epi>
__device__ __forceinline__ void gemm_phase(PG8_LAS unsigned char* lds, const Gemm g, const StaticOrder& S, const Epi& E) {
    int tid = threadIdx.x; asm volatile("" : "+v"(tid));
    const int wid = __builtin_amdgcn_readfirstlane(tid >> 6), lane = tid & 63, wr = wid >> 2, wc = wid & 3, fr = lane & 15, fq = lane >> 4;
    int nt = g.K / BK; asm volatile("" : "+s"(nt));
    unsigned voffA[2], voffB[2];
#pragma unroll
    for (int i = 0; i < 2; ++i) { int R, C; stage_rc(tid * 16 + i * 8192, R, C); const int Rb = Epi::PERM ? ((R & ~31) + perm32(R & 31)) : R;
        voffA[i] = (unsigned)(R * g.lda + C) * 2u; voffB[i] = (unsigned)(Rb * g.ldb + C) * 2u; }
    const size_t kstep = (size_t)(BK * 2);
    const size_t hstepA = (size_t)HALF * g.lda * 2, hstepB = (size_t)HALF * g.ldb * 2;
    const unsigned ldsw = (unsigned)wid * 1024u;
    const int aoff = lds_byte(wr * 64 + fr, fq * 8), boff = lds_byte(wc * 32 + fr, fq * 8);
#define PG8_ABASE(u) ((const char*)g.A + (size_t)(u).pm * g.a_pm + (size_t)(u).pn * g.a_pn)
#define PG8_BBASE(u) ((const char*)g.Bt + (size_t)(u).pn * g.b_pn + (size_t)((u).pm / g.b_div) * g.b_pq)
#define PG8_SA(b, h) (((b) * 2 + (h)) * HTB)
#define PG8_SB(b, h) ((4 + (b) * 2 + (h)) * HTB)
#define PG8_STAGE(bufoff, gbase, voff) do { _Pragma("unroll") for (int _i = 0; _i < 2; ++_i) \
        __builtin_amdgcn_global_load_lds((const unsigned*)((const char*)(gbase) + (voff)[_i]), (PG8_LAS unsigned*)(lds + (bufoff) + ldsw + _i * 8192), 16, 0, 0); } while (0)
#define PG8_LDA(dst, b, h) do { _Pragma("unroll") for (int m = 0; m < 4; ++m) _Pragma("unroll") for (int k = 0; k < 2; ++k) dst[m][k] = *(const PG8_LAS bf16x8*)(lds + PG8_SA(b, h) + aoff + m * 2048 + k * 1024); } while (0)
#define PG8_LDB(dst, b, h) do { _Pragma("unroll") for (int n = 0; n < 2; ++n) _Pragma("unroll") for (int k = 0; k < 2; ++k) dst[n][k] = *(const PG8_LAS bf16x8*)(lds + PG8_SB(b, h) + boff + n * 2048 + k * 1024); } while (0)
#define PG8_MMA(ai, bj, At, Bt) do { __builtin_amdgcn_s_setprio(1); _Pragma("unroll") for (int m = 0; m < 4; ++m) _Pragma("unroll") for (int n = 0; n < 2; ++n) _Pragma("unroll") for (int k = 0; k < 2; ++k) \
        acc[ai][bj][m][n] = __builtin_amdgcn_mfma_f32_16x16x32_bf16(Bt[n][k], At[m][k], acc[ai][bj][m][n], 0, 0, 0); __builtin_amdgcn_s_setprio(0); } while (0)
#define PG8_WAIT_V(n) asm volatile("s_waitcnt vmcnt(" #n ")" ::: "memory")
#define PG8_WAIT_L(n) asm volatile("s_waitcnt lgkmcnt(" #n ")" ::: "memory")
#define PG8_BAR __builtin_amdgcn_s_barrier()
#define PG8_SCHED __builtin_amdgcn_sched_barrier(0)
    Unit cur, nxt; int ui = 0;
    if (!S.next(0, cur)) return;
    Acc acc;
#pragma unroll
    for (int a = 0; a < 2; ++a)
#pragma unroll
        for (int b = 0; b < 2; ++b)
#pragma unroll
            for (int m = 0; m < 4; ++m)
#pragma unroll
                for (int n = 0; n < 2; ++n) acc[a][b][m][n] = (f32x4){0.f, 0.f, 0.f, 0.f};
    bf16x8 At[4][2], B0[2][2], B1[2][2];
    const char* cA = PG8_ABASE(cur); const char* cB = PG8_BBASE(cur);
    PG8_STAGE(PG8_SB(0, 0), cB, voffB); PG8_STAGE(PG8_SB(0, 1), cB + hstepB, voffB); PG8_STAGE(PG8_SA(0, 0), cA, voffA); PG8_STAGE(PG8_SA(0, 1), cA + hstepA, voffA);
    if (wr == 1) PG8_BAR;
    PG8_WAIT_V(2); PG8_BAR;
    PG8_STAGE(PG8_SB(1, 0), cB + kstep, voffB); PG8_STAGE(PG8_SA(1, 0), cA + kstep, voffA); PG8_STAGE(PG8_SB(1, 1), cB + hstepB + kstep, voffB);
    PG8_WAIT_V(6); PG8_BAR;
    for (;;) {
        const bool has_next = S.next(ui + 1, nxt);
        const char* nA = has_next ? PG8_ABASE(nxt) : cA; const char* nB = has_next ? PG8_BBASE(nxt) : cB;
        for (int t = 0; t < nt; t += 2) {
            const bool last = (t == nt - 2);
            const char* a1 = cA + (size_t)(t + 1) * kstep;
            const char* a2 = last ? nA : cA + (size_t)(t + 2) * kstep; const char* b2 = last ? nB : cB + (size_t)(t + 2) * kstep;
            const char* a3 = a2 + kstep; const char* b3 = b2 + kstep;
            PG8_LDB(B0, 0, 0); PG8_LDB(B1, 0, 1); PG8_SCHED; PG8_LDA(At, 0, 0); PG8_STAGE(PG8_SA(1, 1), a1 + hstepA, voffA);
            PG8_WAIT_V(8); PG8_WAIT_L(0); PG8_BAR; PG8_MMA(0, 0, At, B0); PG8_MMA(0, 1, At, B1); PG8_BAR; PG8_SCHED;
            PG8_LDA(At, 0, 1); PG8_STAGE(PG8_SB(0, 0), b2, voffB); PG8_STAGE(PG8_SB(0, 1), b2 + hstepB, voffB); PG8_STAGE(PG8_SA(0, 0), a2, voffA);
            PG8_WAIT_V(8); PG8_WAIT_L(0); PG8_BAR; PG8_MMA(1, 0, At, B0); PG8_MMA(1, 1, At, B1); PG8_BAR; PG8_SCHED;
            PG8_LDB(B0, 1, 0); PG8_LDB(B1, 1, 1); PG8_SCHED; PG8_LDA(At, 1, 0); PG8_STAGE(PG8_SA(0, 1), a2 + hstepA, voffA);
            PG8_WAIT_V(8); PG8_WAIT_L(0); PG8_BAR; PG8_MMA(0, 0, At, B0); PG8_MMA(0, 1, At, B1); PG8_BAR; PG8_SCHED;
            PG8_LDA(At, 1, 1); PG8_STAGE(PG8_SB(1, 0), b3, voffB); PG8_STAGE(PG8_SB(1, 1), b3 + hstepB, voffB); PG8_STAGE(PG8_SA(1, 0), a3, voffA);
            PG8_WAIT_V(8); PG8_WAIT_L(0); PG8_BAR; PG8_MMA(1, 0, At, B0); PG8_MMA(1, 1, At, B1); PG8_BAR; PG8_SCHED;
        }
        if (wr == 0) PG8_BAR;
        E(acc, cur, wr, wc, fr, fq, ui);
        if (!has_next) break;
#pragma unroll
        for (int a = 0; a < 2; ++a)
#pragma unroll
            for (int b = 0; b < 2; ++b)
#pragma unroll
                for (int m = 0; m < 4; ++m)
#pragma unroll
                    for (int n = 0; n < 2; ++n) acc[a][b][m][n] = (f32x4){0.f, 0.f, 0.f, 0.f};
        cur = nxt; cA = nA; cB = nB; ++ui;
        if (wr == 1) PG8_BAR;
    }
    PG8_WAIT_V(0);
    PG8_BAR;
#undef PG8_ABASE
#undef PG8_BBASE
#undef PG8_SA
#undef PG8_SB
#undef PG8_STAGE
#undef PG8_LDA
#undef PG8_LDB
#undef PG8_MMA
#undef PG8_WAIT_V
#undef PG8_WAIT_L
#undef PG8_BAR
#undef PG8_SCHED
}
}

__device__ __forceinline__ void transpose_item(const float* W, int ldw, int k0, int n0, bf16_t* WT, int ldwt, int wrow0, const float* gain, float scale, LAS float* scr, int lane) {
#pragma unroll 8
    for (int i = 0; i < 32; ++i) { const int kk = 2 * i + (lane >> 5); const float gk = gain ? gain[k0 + kk] * scale : scale;
        scr[kk * 33 + (lane & 31)] = W[(size_t)(k0 + kk) * ldw + n0 + (lane & 31)] * gk; }
    LDS_WAIT(); asm volatile("" ::: "memory");
    const int c = lane & 7;
#pragma unroll
    for (int j = 0; j < 4; ++j) { const int n = (lane >> 3) + 8 * j; const LAS float* s = scr + (8 * c) * 33 + n;
        u32x4 o; o.x = pk2(s[0 * 33], s[1 * 33]); o.y = pk2(s[2 * 33], s[3 * 33]); o.z = pk2(s[4 * 33], s[5 * 33]); o.w = pk2(s[6 * 33], s[7 * 33]);
        *(u32x4*)(WT + (size_t)(wrow0 + n) * ldwt + k0 + 8 * c) = o; }
    LDS_WAIT(); asm volatile("" ::: "memory");
}
__device__ __forceinline__ void fourier_fold_item(const float* w_in, const float* gain, bf16_t* Win_t, int item, int lane) {
    const int h = item >> 7, k0 = (item & 127) * 8;
    float w[8], ar[8], ai[8];
#pragma unroll
    for (int kk = 0; kk < 8; ++kk) { w[kk] = w_in[(size_t)(k0 + kk) * 1536 + 1280 + h * 64 + lane] * gain[k0 + kk]; ar[kk] = 0.f; ai[kk] = 0.f; }
#pragma unroll 1
    for (int c = 0; c < 64; ++c) { float sn, cs; sincospif((float)((lane * c) & 63) * (1.0f / 32.0f), &sn, &cs);
#pragma unroll
        for (int kk = 0; kk < 8; ++kk) { const float wv = __builtin_bit_cast(float, __builtin_amdgcn_readlane(__builtin_bit_cast(int, w[kk]), c)); ar[kk] += wv * cs; ai[kk] -= wv * sn; } }
    u32x4 o; o.x = pk2(ar[0] * 0.125f, ar[1] * 0.125f); o.y = pk2(ar[2] * 0.125f, ar[3] * 0.125f); o.z = pk2(ar[4] * 0.125f, ar[5] * 0.125f); o.w = pk2(ar[6] * 0.125f, ar[7] * 0.125f);
    *(u32x4*)(Win_t + (size_t)(1280 + h * 64 + lane) * 1024 + k0) = o;
    o.x = pk2(ai[0] * 0.125f, ai[1] * 0.125f); o.y = pk2(ai[2] * 0.125f, ai[3] * 0.125f); o.z = pk2(ai[4] * 0.125f, ai[5] * 0.125f); o.w = pk2(ai[6] * 0.125f, ai[7] * 0.125f);
    *(u32x4*)(Win_t + (size_t)(1536 + h * 64 + lane) * 1024 + k0) = o;
}
__device__ __forceinline__ void outfold_item(const float* Wsm, const float* sc, const float* w_out, int base, bf16_t* Wout_t, int item, int lane) {
    const int G = item >> 7, n0 = (item & 127) * 8;
    const float* wr_ = Wsm + ((size_t)G * 64 + lane) * 64;
    float acc[8];
#pragma unroll
    for (int i = 0; i < 8; ++i) acc[i] = 0.f;
#pragma unroll 1
    for (int d4 = 0; d4 < 16; ++d4) { const f32x4 wv = *(const f32x4*)(wr_ + 4 * d4);
#pragma unroll
        for (int e = 0; e < 4; ++e) { const int d = 4 * d4 + e; const float s = sc ? sc[G * 64 + d] : 1.f; const float* vr = w_out + (size_t)(base + G * 64 + d) * 1024 + n0;
            const f32x4 v0 = *(const f32x4*)vr, v1 = *(const f32x4*)(vr + 4); const float ws = wv[e] * s;
#pragma unroll
            for (int i = 0; i < 4; ++i) { acc[i] += ws * v0[i]; acc[4 + i] += ws * v1[i]; } } }
#pragma unroll
    for (int i = 0; i < 8; ++i) Wout_t[(size_t)(n0 + i) * 1024 + base + G * 64 + lane] = (bf16_t)f2bf(acc[i]);
}
__device__ __forceinline__ void row_to_bf16_rs(const float* xrow, bf16_t* orow, float* rs_out, int lane) {
    const f32x4* xr = (const f32x4*)xrow + lane;
    f32x4 v[4]; float s = 0.f;
#pragma unroll
    for (int j = 0; j < 4; ++j) { v[j] = xr[64 * j]; s += (v[j].x * v[j].x + v[j].y * v[j].y) + (v[j].z * v[j].z + v[j].w * v[j].w); }
    s = wave_sum(s);
    if (lane == 0) *rs_out = 1.0f / sqrtf(s * (1.f / DM) + RMS_EPS);
    u32x2* o8 = (u32x2*)orow + lane;
#pragma unroll
    for (int j = 0; j < 4; ++j) { u32x2 w; w.x = pk2(v[j].x, v[j].y); w.y = pk2(v[j].z, v[j].w); o8[64 * j] = w; }
}

__device__ __forceinline__ void residual_rows(const float* xin, float* xout, const bf16_t* y, const float* gpost, bf16_t* xb, float* rs, bool write_next, int gw, int NGW, int lane) {
    for (int row = gw; row < MT; row += NGW) {
        const u32x4* yr = (const u32x4*)(y + (size_t)row * DM);
        const u32x4 ya = yr[lane], yb = yr[lane + 64];
        float yv[16];
        yv[0] = bflo(ya.x); yv[1] = bfhi(ya.x); yv[2] = bflo(ya.y); yv[3] = bfhi(ya.y); yv[4] = bflo(ya.z); yv[5] = bfhi(ya.z); yv[6] = bflo(ya.w); yv[7] = bfhi(ya.w);
        yv[8] = bflo(yb.x); yv[9] = bfhi(yb.x); yv[10] = bflo(yb.y); yv[11] = bfhi(yb.y); yv[12] = bflo(yb.z); yv[13] = bfhi(yb.z); yv[14] = bflo(yb.w); yv[15] = bfhi(yb.w);
        float ss = 0.f;
#pragma unroll
        for (int i = 0; i < 16; ++i) ss += yv[i] * yv[i];
        ss = wave_sum(ss);
        const float r = 1.0f / sqrtf(ss * (1.f / DM) + RMS_EPS);
        const f32x4* xr = (const f32x4*)(xin + (size_t)row * DM); const f32x4* gr = (const f32x4*)gpost;
        f32x4 xv[4];
        float ss2 = 0.f;
#pragma unroll
        for (int q = 0; q < 4; ++q) { const int idx = (q >> 1) * 128 + 2 * lane + (q & 1); const f32x4 x4 = xr[idx], g4 = gr[idx];
#pragma unroll
            for (int i = 0; i < 4; ++i) { const float v = x4[i] + yv[q * 4 + i] * r * g4[i]; xv[q][i] = v; ss2 += v * v; } }
        f32x4* xo = (f32x4*)(xout + (size_t)row * DM);
#pragma unroll
        for (int q = 0; q < 4; ++q) xo[(q >> 1) * 128 + 2 * lane + (q & 1)] = xv[q];
        if (write_next) {
            ss2 = wave_sum(ss2);
            if (lane == 0) rs[row] = 1.0f / sqrtf(ss2 * (1.f / DM) + RMS_EPS);
            u32x4* bo = (u32x4*)(xb + (size_t)row * DM);
            u32x4 w; w.x = pk2(xv[0][0], xv[0][1]); w.y = pk2(xv[0][2], xv[0][3]); w.z = pk2(xv[1][0], xv[1][1]); w.w = pk2(xv[1][2], xv[1][3]); bo[lane] = w;
            w.x = pk2(xv[2][0], xv[2][1]); w.y = pk2(xv[2][2], xv[2][3]); w.z = pk2(xv[3][0], xv[3][1]); w.w = pk2(xv[3][2], xv[3][3]); bo[lane + 64] = w;
        }
    }
}
__device__ __forceinline__ void pool_items(const bf16_t* z, bf16_t* cat, int gtid, int NT) {
    for (int idx = gtid; idx < MT * 32; idx += NT) {
        const int token = idx >> 5, c8 = idx & 31, ch = c8 * 8, g = c8 >> 3, win = 2 << g, left = win >> 1, right = win - 1 - left;
        const int t = token & (SEQ - 1), base = token - t;
        const int lo = (t - left) < 0 ? 0 : (t - left), hi = (t + right) > (SEQ - 1) ? (SEQ - 1) : (t + right);
        float sum[8];
#pragma unroll
        for (int i = 0; i < 8; ++i) sum[i] = 0.f;
        for (int r = lo; r <= hi; ++r) { const u32x4 v = *(const u32x4*)(z + (size_t)(base + r) * NZ + ch);
            sum[0] += bflo(v.x); sum[1] += bfhi(v.x); sum[2] += bflo(v.y); sum[3] += bfhi(v.y); sum[4] += bflo(v.z); sum[5] += bfhi(v.z); sum[6] += bflo(v.w); sum[7] += bfhi(v.w); }
        const u32x4 o = *(const u32x4*)(z + (size_t)token * NZ + ch);
        const float inv = 1.0f / (float)(hi - lo + 1);
        u32x4 w;
        w.x = pk2(sum[0] * inv - bflo(o.x), sum[1] * inv - bfhi(o.x)); w.y = pk2(sum[2] * inv - bflo(o.y), sum[3] * inv - bfhi(o.y));
        w.z = pk2(sum[4] * inv - bflo(o.z), sum[5] * inv - bfhi(o.z)); w.w = pk2(sum[6] * inv - bflo(o.w), sum[7] * inv - bfhi(o.w));
        *(u32x4*)(cat + (size_t)token * DM + ch) = w;
    }
}
__device__ __forceinline__ void sgu_chunk(LAS unsigned char* lds, const bf16_t* z, bf16_t* cat, const bf16_t* wsb, const float* gnorm, const float* bias, int chunk, int tid, int wid, int lane) {
    LAS float* stat = (LAS float*)lds;
    LAS bf16_t* vT = (LAS bf16_t*)(lds + 1024);
    const int tok0 = chunk * 128, fr = lane & 15, fq = lane >> 4;
    __syncthreads();
#pragma unroll 4
    for (int i = 0; i < 16; ++i) { const int row = wid * 16 + i;
        const u32x4 v = *(const u32x4*)(z + (size_t)(tok0 + row) * NZ + 768 + lane * 8);
        float x[8]; x[0] = bflo(v.x); x[1] = bfhi(v.x); x[2] = bflo(v.y); x[3] = bfhi(v.y); x[4] = bflo(v.z); x[5] = bfhi(v.z); x[6] = bflo(v.w); x[7] = bfhi(v.w);
        float s = 0.f;
#pragma unroll
        for (int e = 0; e < 8; ++e) s += x[e];
        const float mean = wave_sum(s) * (1.f / 512.f); float q = 0.f;
#pragma unroll
        for (int e = 0; e < 8; ++e) { const float d = x[e] - mean; q += d * d; }
        const float rstd = 1.0f / sqrtf(wave_sum(q) * (1.f / 512.f) + LN_EPS);
        if (lane == 0) { stat[row * 2] = mean; stat[row * 2 + 1] = rstd; } }
    __syncthreads();
    for (int h = 0; h < 4; ++h) {
        if (h) __syncthreads();
#pragma unroll
        for (int it = 0; it < 4; ++it) { const int idx = it * 512 + tid, row = idx >> 4, cb = idx & 15;
            const u32x4 v = *(const u32x4*)(z + (size_t)(tok0 + row) * NZ + 768 + h * 128 + cb * 8);
            const f32x4 g0 = *(const f32x4*)(gnorm + h * 128 + cb * 8), g1 = *(const f32x4*)(gnorm + h * 128 + cb * 8 + 4);
            const float mean = stat[row * 2], rstd = stat[row * 2 + 1];
            LAS bf16_t* d = vT + (cb * 8) * 136 + row;
            d[0 * 136] = (bf16_t)f2bf((bflo(v.x) - mean) * rstd * g0[0]); d[1 * 136] = (bf16_t)f2bf((bfhi(v.x) - mean) * rstd * g0[1]);
            d[2 * 136] = (bf16_t)f2bf((bflo(v.y) - mean) * rstd * g0[2]); d[3 * 136] = (bf16_t)f2bf((bfhi(v.y) - mean) * rstd * g0[3]);
            d[4 * 136] = (bf16_t)f2bf((bflo(v.z) - mean) * rstd * g1[0]); d[5 * 136] = (bf16_t)f2bf((bfhi(v.z) - mean) * rstd * g1[1]);
            d[6 * 136] = (bf16_t)f2bf((bflo(v.w) - mean) * rstd * g1[2]); d[7 * 136] = (bf16_t)f2bf((bfhi(v.w) - mean) * rstd * g1[3]); }
        __syncthreads();
        bf16x8 Y[4];
#pragma unroll
        for (int kk = 0; kk < 4; ++kk) Y[kk] = *(const bf16x8*)(wsb + ((size_t)(h * 128 + wid * 16 + fr)) * 128 + kk * 32 + fq * 8);
        const int token = tok0 + wid * 16 + fr; const float bs = bias[h * 128 + wid * 16 + fr];
#pragma unroll
        for (int cb = 0; cb < 8; ++cb) { f32x4 a = (f32x4){0.f, 0.f, 0.f, 0.f};
#pragma unroll
            for (int kk = 0; kk < 4; ++kk) { const bf16x8 X = *(const LAS bf16x8*)(vT + (cb * 16 + fr) * 136 + kk * 32 + fq * 8); a = __builtin_amdgcn_mfma_f32_16x16x32_bf16(X, Y[kk], a, 0, 0, 0); }
            const int ch = h * 128 + cb * 16 + 4 * fq;
            const u32x2 uu = *(const u32x2*)(z + (size_t)token * NZ + 256 + ch);
            u32x2 w; w.x = pk2(bflo(uu.x) * (a[0] + bs), bfhi(uu.x) * (a[1] + bs)); w.y = pk2(bflo(uu.y) * (a[2] + bs), bfhi(uu.y) * (a[3] + bs));
            *(u32x2*)(cat + (size_t)token * DM + 256 + ch) = w; }
    }
}
__device__ __forceinline__ void t1_job(LAS unsigned char* lds, const bf16_t* z, bf16_t* A1, int job, int tid, int wid, int lane) {
    const int b = job >> 7, s2 = job & 127;
    LAS unsigned* tile = (LAS unsigned*)lds;
    __syncthreads();
#pragma unroll
    for (int i = 0; i < 8; ++i) { const int s1 = wid * 8 + i;
        const u32x4 v = *(const u32x4*)(z + (size_t)(b * SEQ + 128 * s1 + s2) * NZ + 1280 + lane * 8);
        LAS unsigned* d = tile + s1 * 257 + lane * 4; d[0] = v.x; d[1] = v.y; d[2] = v.z; d[3] = v.w; }
    __syncthreads();
    const LAS unsigned short* t16 = (const LAS unsigned short*)lds;
#pragma unroll
    for (int it = 0; it < 8; ++it) { const int idx = it * 512 + tid, s1b = idx & 7, ri = (idx >> 3) & 1, c = idx >> 4;
        const LAS unsigned short* s = t16 + (s1b * 8) * 514 + ri * 256 + c;
        u32x4 w; w.x = (unsigned)s[0 * 514] | ((unsigned)s[1 * 514] << 16); w.y = (unsigned)s[2 * 514] | ((unsigned)s[3 * 514] << 16);
        w.z = (unsigned)s[4 * 514] | ((unsigned)s[5 * 514] << 16); w.w = (unsigned)s[6 * 514] | ((unsigned)s[7 * 514] << 16);
        *(u32x4*)(A1 + ((size_t)((b * 256 + c) * 128 + s2)) * 128 + ri * 64 + s1b * 8) = w; }
}

#define XB_TMO      128
#define XB_XCNT(j)  (256  + 64 * (j))
#define XB_XSUB(j)  (1280 + 64 * (j))
#define XB_XGEN(j)  (2304 + 64 * (j))
#define XB_TOP      3328
#define XB_TOPGEN   3392
#define XCD_BAR_WORDS 3456
#define XB_SPIN_CAP (1u << 18)
__device__ __forceinline__ unsigned xb_ld(unsigned* p)              { return __hip_atomic_load(p, __ATOMIC_RELAXED, __HIP_MEMORY_SCOPE_AGENT); }
__device__ __forceinline__ unsigned xb_add(unsigned* p, unsigned v) { return __hip_atomic_fetch_add(p, v, __ATOMIC_RELAXED, __HIP_MEMORY_SCOPE_AGENT); }
__device__ __forceinline__ unsigned xb_xcc_id() { return (unsigned)__builtin_amdgcn_s_getreg((3 << 11) | 20) & 0xFu; }
#define XB_SPIN(cond, bar) do { unsigned _sp = 0; while (cond) { __builtin_amdgcn_s_sleep(1); \
    if ((++_sp & 255u) == 0u) { if (xb_ld(&(bar)[XB_TMO])) break; if (_sp > XB_SPIN_CAP) { atomicAdd(&(bar)[XB_TMO], 1u); break; } } } } while (0)
struct XcdBarrier { unsigned* bar; unsigned x; volatile LAS unsigned* st; };
__device__ __forceinline__ XcdBarrier xcd_barrier_post(unsigned* bar, volatile LAS unsigned* st) {
    XcdBarrier b; b.bar = bar; b.x = xb_xcc_id(); b.st = st;
    if (threadIdx.x == 0) (void)xb_add(&bar[XB_XCNT(b.x)], 1u);
    return b;
}
__device__ __forceinline__ void xcd_barrier_complete(unsigned* bar, unsigned x, unsigned& nloc, unsigned& nx) {
    const unsigned G = gridDim.x * gridDim.y * gridDim.z;
    unsigned sum, cnt, mine, sp = 0u;
    for (;;) {
        sum = 0u; cnt = 0u; mine = 0u;
#pragma unroll
        for (unsigned j = 0; j < 16; ++j) { const unsigned c = xb_ld(&bar[XB_XCNT(j)]); sum += c; cnt += (c > 0u) ? 1u : 0u; mine = (j == x) ? c : mine; }
        if (sum == G) break;
        __builtin_amdgcn_s_sleep(1);
        if ((++sp & 255u) == 0u) { if (xb_ld(&bar[XB_TMO])) break; if (sp > XB_SPIN_CAP) { atomicAdd(&bar[XB_TMO], 1u); break; } }
    }
    nloc = mine > 0u ? mine : 1u; nx = cnt > 0u ? cnt : 1u;
}
__device__ __forceinline__ void xcd_barrier(const XcdBarrier& b) {
    asm volatile("s_waitcnt vmcnt(0)" ::: "memory");
    __syncthreads();
    if (threadIdx.x == 0) {
        unsigned* bar = b.bar;
        __builtin_amdgcn_s_waitcnt(0);
        unsigned nloc = b.st[0], nx = b.st[1];
        if (nloc == 0u) { xcd_barrier_complete(bar, b.x, nloc, nx); b.st[0] = nloc; b.st[1] = nx; }
        const unsigned old = xb_add(&bar[XB_XSUB(b.x)], 1u);
        const unsigned gen = old / nloc;
        if (old + 1u == (gen + 1u) * nloc) {
            __builtin_amdgcn_fence(__ATOMIC_RELEASE, "agent");
            asm volatile("s_waitcnt vmcnt(0)" ::: "memory");
            const unsigned og = xb_add(&bar[XB_TOP], 1u);
            const unsigned tg = og / nx;
            if (og + 1u == (tg + 1u) * nx) xb_add(&bar[XB_TOPGEN], 1u);
            else XB_SPIN(xb_ld(&bar[XB_TOPGEN]) == tg, bar);
            __builtin_amdgcn_fence(__ATOMIC_ACQUIRE, "agent");
            xb_add(&bar[XB_XGEN(b.x)], 1u);
            asm volatile("s_waitcnt vmcnt(0)" ::: "memory");
        } else {
            XB_SPIN(xb_ld(&bar[XB_XGEN(b.x)]) == gen, bar);
            __builtin_amdgcn_fence(__ATOMIC_ACQUIRE, "agent");
            asm volatile("s_waitcnt vmcnt(0)" ::: "memory");
        }
    }
    __syncthreads();
}

struct Args { const float* in[24]; float* out; unsigned char* ws; int ph_lo, ph_hi; };
constexpr int PH_PER_LAYER = 14, N_PHASES = 1 + NL * PH_PER_LAYER;

__global__ void __launch_bounds__(512, 2) enc_fwd(Args args) {
    extern __shared__ __attribute__((aligned(16))) unsigned char lds_raw[];
    LAS unsigned char* lds = (LAS unsigned char*)lds_raw;
    cg::grid_group grid = cg::this_grid();
    const int G = gridDim.x, bid = blockIdx.x, NGW = G * 8, NT = G * 512;
#define TID_BEGIN int tid = threadIdx.x; asm volatile("" : "+v"(tid)); const int lane = tid & 63, wid = __builtin_amdgcn_readfirstlane(tid >> 6), gw = bid * 8 + wid, gtid = bid * 512 + tid; (void)gw; (void)gtid; (void)lane
    unsigned char* ws = args.ws;
    const int lo = args.ph_lo, hi = args.ph_hi;
#define IN(k) (lo <= (k) && (k) < hi)
    if (threadIdx.x < 64) ((LAS unsigned*)(lds + MISC_OFF))[threadIdx.x] = 0u;
    if (bid == 0) for (int i = threadIdx.x; i < 4096; i += 512) ((unsigned*)(ws + WS_BAR))[i] = 0u;
    __syncthreads();
    XcdBarrier xbar; xbar.bar = (unsigned*)(ws + WS_BAR); xbar.x = 0; xbar.st = (volatile LAS unsigned*)(lds + MISC_OFF + 32);
#define SEAM0() do { if (IN(0) && IN(1)) { grid.sync(); xbar = xcd_barrier_post((unsigned*)(ws + WS_BAR), (volatile LAS unsigned*)(lds + MISC_OFF + 32)); } } while (0)
#define SEAM(k) do { if (IN(k) && IN((k) + 1)) xcd_barrier(xbar); } while (0)

#define PH_BEGIN(lv) unsigned char* W = ws; int L = (lv); asm volatile("" : "+s"(W), "+s"(L))
#define PB(off) ((bf16_t*)(W + (off)))
#define PF(off) ((float*)(W + (off)))
#define WLP(off) ((bf16_t*)(W + WS_W + (size_t)L * W_LAYER + (off)))
    if (IN(0) && DBG(0)) REPEAT(0) {
        PH_BEGIN(0); TID_BEGIN;
        bf16_t* F1 = PB(WS_F1); bf16_t* F2 = PB(WS_F2); float* twc = PF(WS_TWC); float* tws = PF(WS_TWS); float* rsmem = PF(WS_RSMEM); float* rs = PF(WS_RS);
        bf16_t* memb = PB(WS_MEMB); bf16_t* xb = PB(WS_XB);
        LAS float* scr = (LAS float*)(lds + wid * 16384);
        constexpr int I_FF = 512, I_OF = 1024, I_TR = 7168, I_SG = 128, I_LAYER = I_FF + I_OF + I_TR + I_SG;
        constexpr int I_F1 = 64, I_F2 = 128, I_TW = 16, I_GLOB = I_F1 + I_F2 + I_TW;
        constexpr int NITEMS = NL * I_LAYER + I_GLOB;
        for (int it = gw; it < NITEMS; it += NGW) {
            int r = it;
            if (r >= NL * I_LAYER) {
                r -= NL * I_LAYER;
                if (r < I_F1) {
#pragma unroll 1
                    for (int e = 0; e < 8; ++e) { const int idx = r * 512 + e * 64 + lane, row = idx >> 7, col = idx & 127, ro = row >> 7, k1 = row & 127, ri = col >> 6, s1 = col & 63;
                        float sn, cs; sincospif((float)((k1 * s1) & 63) * (1.0f / 32.0f), &sn, &cs);
                        float v = (ro == ri) ? cs : (ro == 0 ? sn : -sn); if (k1 >= 64) v = 0.f;
                        F1[idx] = (bf16_t)f2bf(v * 0.125f); }
                } else if (r < I_F1 + I_F2) {
                    r -= I_F1;
#pragma unroll 1
                    for (int e = 0; e < 8; ++e) { const int idx = r * 512 + e * 64 + lane, row = idx >> 8, col = idx & 255, ri = col >> 7, s2 = col & 127;
                        float sn, cs; sincospif((float)((row * s2) & 127) * (1.0f / 64.0f), &sn, &cs);
                        float v = ri ? sn : cs; if (row >= 128) v = 0.f;
                        F2[idx] = (bf16_t)f2bf(v * 0.08838834764831845f); }
                } else {
                    r -= I_F1 + I_F2;
#pragma unroll 1
                    for (int e = 0; e < 8; ++e) { const int idx = r * 512 + e * 64 + lane, k1 = idx >> 7, s2 = idx & 127;
                        float sn, cs; sincospif((float)(k1 * s2) * (1.0f / 4096.0f), &sn, &cs); twc[idx] = cs; tws[idx] = sn; }
                }
                continue;
            }
            const int l = r / I_LAYER; r -= l * I_LAYER;
            unsigned char* wl = ws + WS_W + (size_t)l * W_LAYER;
            bf16_t* Win_t = (bf16_t*)(wl + W_IN); bf16_t* Wout_t = (bf16_t*)(wl + W_OUT);
            const float* w_in = args.in[3] + (size_t)l * 1024 * 1536; const float* w_out = args.in[10] + (size_t)l * 1024 * 1024;
            if (r < I_FF) { fourier_fold_item(w_in, args.in[2] + l * 1024, Win_t, r, lane); continue; } r -= I_FF;
            if (r < I_OF) {
                if (r < 512) outfold_item(args.in[4] + (size_t)l * 4 * 64 * 64, args.in[5] + l * 256, w_out, 0, Wout_t, r, lane);
                else outfold_item(args.in[9] + (size_t)l * 4 * 64 * 64, nullptr, w_out, 768, Wout_t, r - 512, lane);
                continue; } r -= I_OF;
            if (r < I_TR) {
                if (r < 640) { transpose_item(w_in, 1536, 64 * (r / 40), 32 * (r % 40), Win_t, 1024, 32 * (r % 40), args.in[2] + l * 1024, 1.f, scr, lane); continue; } r -= 640;
                if (r < 256) { transpose_item(w_out, 1024, 256 + 64 * (r / 32), 32 * (r % 32), Wout_t, 1024, 32 * (r % 32), nullptr, 1.f, scr, lane); continue; } r -= 256;
                if (r < 2048) { const int which = r >> 9, rr = r & 511;
                    const float* W = args.in[14 + which] + (size_t)l * 1024 * 1024;
                    const float* gn = which == 0 ? args.in[12] + l * 1024 : (which == 3 ? nullptr : args.in[13] + l * 1024);
                    transpose_item(W, 1024, 64 * (rr / 32), 32 * (rr % 32), (bf16_t*)(wl + W_Q + (size_t)which * 2 * MiB), 1024, 32 * (rr % 32), gn, which == 0 ? 0.0625f : 1.f, scr, lane); continue; } r -= 2048;
                if (r < 2816) { const int which = r / 1408, rr = r % 1408, n0 = 32 * (rr % 88);
                    transpose_item(args.in[20 + which] + (size_t)l * 1024 * FF, FF, 64 * (rr / 88), n0, (bf16_t*)(wl + W_GU), 1024, (n0 >> 7) * 256 + which * 128 + (n0 & 127), args.in[19] + l * 1024, 1.f, scr, lane); continue; } r -= 2816;
                transpose_item(args.in[22] + (size_t)l * FF * 1024, 1024, 64 * (r / 32), 32 * (r % 32), (bf16_t*)(wl + W_D), FF, 32 * (r % 32), nullptr, 1.f, scr, lane);
                continue; } r -= I_TR;
            {
                const float* src = args.in[7] + (size_t)l * 65536 + r * 512 + lane * 8; bf16_t* dst = (bf16_t*)(wl + W_SGU) + r * 512 + lane * 8;
                const f32x4 a = *(const f32x4*)src, b = *(const f32x4*)(src + 4);
                u32x4 w; w.x = pk2(a[0], a[1]); w.y = pk2(a[2], a[3]); w.z = pk2(b[0], b[1]); w.w = pk2(b[2], b[3]); *(u32x4*)dst = w;
            }
        }
        for (int m = gw; m < MROWS; m += NGW) row_to_bf16_rs(args.in[1] + (size_t)m * DM, memb + (size_t)m * DM, rsmem + m, lane);
        for (int m = gw; m < MT; m += NGW) row_to_bf16_rs(args.in[0] + (size_t)m * DM, xb + (size_t)m * DM, rs + m, lane);
    }
    SEAM0();

#pragma unroll 1
    for (int l = 0; l < NL; ++l) {
        const int p0 = 1 + l * PH_PER_LAYER;
        if (IN(p0 + 0)) {
            if (DBG(1)) { PH_BEGIN(l); pg8::Gemm g = pg8::mk_gemm(PB(WS_XB), DM, WLP(W_IN), DM, DM, MT / 256, NZ / 256); pg8::StaticOrder S; S.init(g.nM, g.nN, G, bid, REPS(1));
              pg8::EpiRow E{PB(WS_R + R_Z), NZ, PF(WS_RS)}; pg8::gemm_phase(lds, g, S, E); }
            if (l == 0 && DBG(2)) {
#pragma unroll 1
                for (int l2 = 0; l2 < NL; ++l2) {
                    { PH_BEGIN(l2); pg8::Gemm g = pg8::mk_gemm(PB(WS_MEMB), DM, WLP(W_K), DM, DM, 4, 4); pg8::StaticOrder S; S.init(4, 4, G, (bid + G - (128 + 32 * l2) % G) % G, REPS(2));
                      pg8::EpiRow E{PB(WS_KB) + (size_t)L * MROWS * DM, DM, PF(WS_RSMEM)}; pg8::gemm_phase(lds, g, S, E); }
                    { PH_BEGIN(l2); pg8::Gemm g = pg8::mk_gemm(WLP(W_V), DM, PB(WS_MEMB), DM, DM, 4, 4); pg8::StaticOrder S; S.init(4, 4, G, (bid + G - (144 + 32 * l2) % G) % G, REPS(2));
                      pg8::EpiCol E{PB(WS_VT) + (size_t)L * MROWS * DM, DM, PF(WS_RSMEM)}; pg8::gemm_phase(lds, g, S, E); }
                }
            }
        }
        SEAM(p0 + 0);
        if (IN(p0 + 1) && DBG(3)) REPEAT(3) {
            PH_BEGIN(l); TID_BEGIN;
            const bf16_t* zb = PB(WS_R + R_Z); bf16_t* cat = PB(WS_R + R_CAT);
            for (int j = bid; j < 512; j += G) t1_job(lds, zb, PB(WS_R + R_A1), j, tid, wid, lane);
            for (int j = bid; j < 256; j += G) sgu_chunk(lds, zb, cat, WLP(W_SGU), args.in[6] + L * 512, args.in[8] + L * 512, j, tid, wid, lane);
            pool_items(zb, cat, gtid, NT);
            __syncthreads();
        }
        SEAM(p0 + 1);
        if (IN(p0 + 2) && DBG(4)) {
            PH_BEGIN(l);
            pg8::Gemm g = pg8::mk_gemm(PB(WS_F1), 128, PB(WS_R + R_A1), 128, 128, 1, 512); pg8::StaticOrder S; S.init(1, 512, G, bid, REPS(4));
            pg8::EpiFFT1 E{PB(WS_R + R_A2), PF(WS_TWC), PF(WS_TWS)}; pg8::gemm_phase(lds, g, S, E);
        }
        SEAM(p0 + 2);
        if (IN(p0 + 3) && DBG(5)) {
            PH_BEGIN(l);
            pg8::Gemm g = pg8::mk_gemm(PB(WS_F2), 256, PB(WS_R + R_A2), 256, 256, 1, 256); pg8::StaticOrder S; S.init(1, 256, G, bid, REPS(5));
            pg8::EpiFFT2 E{PB(WS_R + R_CAT)}; pg8::gemm_phase(lds, g, S, E);
        }
        SEAM(p0 + 3);
        if (IN(p0 + 4) && DBG(6)) {
            PH_BEGIN(l);
            pg8::Gemm g = pg8::mk_gemm(PB(WS_R + R_CAT), DM, WLP(W_OUT), DM, DM, MT / 256, 4); pg8::StaticOrder S; S.init(g.nM, g.nN, G, bid, REPS(6));
            pg8::EpiRow E{PB(WS_Y), DM, nullptr}; pg8::gemm_phase(lds, g, S, E);
        }
        SEAM(p0 + 4);
        if (IN(p0 + 5) && DBG(7)) { if (REPS(7) > 1) { PH_BEGIN(l); TID_BEGIN; residual_rows(args.in[0], (float*)(W + WS_R), PB(WS_Y), args.in[11] + L * 1024, PB(WS_R + 128 * MiB), PF(WS_R + 200 * MiB), true, gw, NGW, lane); } }
        if (IN(p0 + 5) && DBG(7)) { PH_BEGIN(l); TID_BEGIN; residual_rows(L == 0 ? args.in[0] : args.out, args.out, PB(WS_Y), args.in[11] + L * 1024, PB(WS_XB), PF(WS_RS), true, gw, NGW, lane); }
        SEAM(p0 + 5);
        if (IN(p0 + 6) && DBG(8)) {
            PH_BEGIN(l);
            pg8::Gemm g = pg8::mk_gemm(PB(WS_XB), DM, WLP(W_Q), DM, DM, MT / 256, 4); pg8::StaticOrder S; S.init(g.nM, g.nN, G, bid, REPS(8));
            pg8::EpiRow E{PB(WS_R + R_Q), DM, PF(WS_RS)}; pg8::gemm_phase(lds, g, S, E);
        }
        SEAM(p0 + 6);
        if (IN(p0 + 7) && DBG(9)) {
            PH_BEGIN(l);
            pg8::Gemm g = pg8::mk_gemm(PB(WS_R + R_Q), DM, PB(WS_KB) + (size_t)L * MROWS * DM, DM, 256, MT / 256, 4); g.a_pn = 512; g.b_pn = 512; g.b_pq = 512L * DM; g.b_div = 32;
            pg8::StaticOrder S; S.init(g.nM, g.nN, G, bid, REPS(9));
            pg8::EpiSoftmax E{PB(WS_R + R_P), DM, lds + XCH_OFF}; pg8::gemm_phase(lds, g, S, E);
        }
        SEAM(p0 + 7);
        if (IN(p0 + 8) && DBG(10)) {
            PH_BEGIN(l);
            pg8::Gemm g = pg8::mk_gemm(PB(WS_R + R_P), DM, PB(WS_VT) + (size_t)L * MROWS * DM, DM, 256, MT / 256, 4); g.a_pn = 512; g.b_pn = 512L * DM; g.b_pq = 512; g.b_div = 32;
            pg8::StaticOrder S; S.init(g.nM, g.nN, G, bid, REPS(10));
            pg8::EpiRow E{PB(WS_R + R_Q), DM, nullptr}; pg8::gemm_phase(lds, g, S, E);
        }
        SEAM(p0 + 8);
        if (IN(p0 + 9) && DBG(11)) {
            PH_BEGIN(l);
            pg8::Gemm g = pg8::mk_gemm(PB(WS_R + R_Q), DM, WLP(W_O), DM, DM, MT / 256, 4); pg8::StaticOrder S; S.init(g.nM, g.nN, G, bid, REPS(11));
            pg8::EpiRow E{PB(WS_Y), DM, nullptr}; pg8::gemm_phase(lds, g, S, E);
        }
        SEAM(p0 + 9);
        if (IN(p0 + 10) && DBG(7)) { if (REPS(7) > 1) { PH_BEGIN(l); TID_BEGIN; residual_rows(args.in[0], (float*)(W + WS_R), PB(WS_Y), args.in[18] + L * 1024, PB(WS_R + 128 * MiB), PF(WS_R + 200 * MiB), true, gw, NGW, lane); } }
        if (IN(p0 + 10) && DBG(7)) { PH_BEGIN(l); TID_BEGIN; residual_rows(args.out, args.out, PB(WS_Y), args.in[18] + L * 1024, PB(WS_XB), PF(WS_RS), true, gw, NGW, lane); }
        SEAM(p0 + 10);
        if (IN(p0 + 11) && DBG(12)) {
            PH_BEGIN(l);
            pg8::Gemm g = pg8::mk_gemm(PB(WS_XB), DM, WLP(W_GU), DM, DM, MT / 256, FF2 / 256); pg8::StaticOrder S; S.init(g.nM, g.nN, G, bid, REPS(12));
            pg8::EpiSwiGLU E{PB(WS_R + R_ACT), FF, PF(WS_RS)}; pg8::gemm_phase(lds, g, S, E);
        }
        SEAM(p0 + 11);
        if (IN(p0 + 12) && DBG(13)) {
            PH_BEGIN(l);
            pg8::Gemm g = pg8::mk_gemm(PB(WS_R + R_ACT), FF, WLP(W_D), FF, FF, MT / 256, 4); pg8::StaticOrder S; S.init(g.nM, g.nN, G, bid, REPS(13));
            pg8::EpiRow E{PB(WS_Y), DM, nullptr}; pg8::gemm_phase(lds, g, S, E);
        }
        SEAM(p0 + 12);
        if (IN(p0 + 13) && DBG(7)) { if (REPS(7) > 1) { PH_BEGIN(l); TID_BEGIN; residual_rows(args.in[0], (float*)(W + WS_R), PB(WS_Y), args.in[23] + L * 1024, PB(WS_R + 128 * MiB), PF(WS_R + 200 * MiB), true, gw, NGW, lane); } }
        if (IN(p0 + 13) && DBG(7)) { PH_BEGIN(l); TID_BEGIN; residual_rows(args.out, args.out, PB(WS_Y), args.in[23] + L * 1024, PB(WS_XB), PF(WS_RS), L + 1 < NL, gw, NGW, lane); }
        SEAM(p0 + 13);
    }
#undef IN
#undef SEAM
#undef SEAM0
}

extern "C" void kernel_launch(void* const* d_in, const int* in_sizes, int n_in, void* d_out, int out_size, void* d_ws, size_t ws_size, hipStream_t stream) {
    static int grid = 0;
    if (grid == 0) {
        if (n_in != 24 || in_sizes[0] != MT * DM || out_size != MT * DM || ws_size < WS_END) { fprintf(stderr, "kernel_launch: unexpected shapes (n_in %d, ws %zu)\n", n_in, ws_size); grid = -1; return; }
        int dev = 0, cus = 0, per_cu = 0;
        if (hipGetDevice(&dev) != hipSuccess || hipDeviceGetAttribute(&cus, hipDeviceAttributeMultiprocessorCount, dev) != hipSuccess) { grid = -1; return; }
        if (hipFuncSetAttribute((const void*)enc_fwd, hipFuncAttributeMaxDynamicSharedMemorySize, LDS_BYTES) != hipSuccess) { fprintf(stderr, "kernel_launch: hipFuncSetAttribute failed\n"); grid = -1; return; }
        if (hipOccupancyMaxActiveBlocksPerMultiprocessor(&per_cu, (const void*)enc_fwd, 512, LDS_BYTES) != hipSuccess || per_cu < 1) { fprintf(stderr, "kernel_launch: occupancy query gives %d\n", per_cu); (void)hipGetLastError(); grid = -1; return; }
        grid = cus * per_cu;
    }
    if (grid < 0) return;
    Args a{};
    for (int i = 0; i < 24; ++i) a.in[i] = (const float*)d_in[i];
    a.out = (float*)d_out; a.ws = (unsigned char*)d_ws;
#if MK_PER_PHASE
    for (int p = 0; p < N_PHASES; ++p) { a.ph_lo = p; a.ph_hi = p + 1; hipLaunchKernelGGL(enc_fwd, dim3(grid), dim3(512), LDS_BYTES, stream, a); }
#else
    a.ph_lo = 0; a.ph_hi = N_PHASES;
    void* kargs[] = {&a};
    hipError_t e = hipLaunchCooperativeKernel((const void*)enc_fwd, dim3(grid), dim3(512), kargs, LDS_BYTES, stream);
    if (e != hipSuccess) fprintf(stderr, "kernel_launch: cooperative launch failed: %s (grid %d)\n", hipGetErrorString(e), grid);
#endif
}
```
